# Optimizing an MI355X kernel written in HIP

```python
import math
import jax
import jax.numpy as jnp
from jax import lax
import numpy as np

D_MODEL = 1024
BATCH = 1
SEQ = 16384
DEPTH = 4

GRID_W = 64
CTX_LEN = 256

ATT_HEADS = 8
ATT_KV_HEADS = 2
ATT_Q_PER_KV = ATT_HEADS // ATT_KV_HEADS
HEAD_DIM = 64
WINDOW = 128
ATT_BLOCK = 128
ROPE_PAIRS = HEAD_DIM // 4
ROPE_BASE = 10000.0
BRANCH_W = 512
N_BRANCHES = 4
POOL_WINDOWS = (2, 4, 8, 16)
POOL_GROUPS = 4
POOL_GW = BRANCH_W // POOL_GROUPS
HY_ORDER = 2
HY_EMB = 33
HY_BANDS = (HY_EMB - 1) // 2
HY_HIDDEN = 64
HY_TARGET = 1e-2
HY_FAST_PCT = 0.3
HY_SLOW_PCT = 1.5
HY_MOD_SHIFT = 0.05
HY_FILT_OUT = HY_ORDER * 2 * BRANCH_W
Q_COLS = ATT_HEADS * HEAD_DIM
KV_COLS = ATT_KV_HEADS * HEAD_DIM
POOL_COLS = BRANCH_W
HY_COLS = (HY_ORDER + 1) * BRANCH_W
SC_COLS = 3 * BRANCH_W
GATE_COLS = N_BRANCHES * D_MODEL
IN_COLS = Q_COLS + 2 * KV_COLS + POOL_COLS + HY_COLS + SC_COLS + GATE_COLS
N_GROUPS = 4
EXPERTS_PER_GROUP = 8
N_EXPERTS = N_GROUPS * EXPERTS_PER_GROUP
TOP_K = 2
EXPERT_HIDDEN = 512
EXPERT_BLOCK = 128
DEEPNORM_ALPHA = (2 * DEPTH) ** 0.25
DEEPNORM_BETA = (8 * DEPTH) ** -0.25
LN_EPS = 1e-6
NEG_INF = -1e30

kernel_name = "hybrid_gated_branch_diffusion_trunk"


def layer_norm(x):
    xf = x.astype(jnp.float32)
    mu = jnp.mean(xf, axis=-1, keepdims=True)
    var = jnp.mean(jnp.square(xf - mu), axis=-1, keepdims=True)
    return ((xf - mu) * lax.rsqrt(var + LN_EPS)).astype(x.dtype)


def layer_norm_affine(x, g, b):
    return layer_norm(x) * g + b


def modulate(x, shift, scale):
    return layer_norm(x) * (1.0 + scale) + shift


def split_cols(p):
    sizes = (Q_COLS, KV_COLS, KV_COLS, POOL_COLS, HY_COLS, SC_COLS, GATE_COLS)
    idx = [int(v) for v in np.cumsum(sizes)[:-1]]
    return jnp.split(p, idx, axis=-1)


def conv3_centred(u, w):
    up = jnp.pad(u, ((0, 0), (1, 1), (0, 0)))
    return up[:, :-2] * w[0] + up[:, 1:-1] * w[1] + up[:, 2:] * w[2]


def axial_rope_tables(rows):
    r, col = jnp.meshgrid(jnp.arange(rows), jnp.arange(GRID_W), indexing="ij")
    r = r.reshape(-1).astype(jnp.float32)
    col = col.reshape(-1).astype(jnp.float32)
    inv = ROPE_BASE ** (-jnp.arange(ROPE_PAIRS, dtype=jnp.float32) / ROPE_PAIRS)
    ang = jnp.stack([r[:, None] * inv, col[:, None] * inv], axis=1)
    return jnp.cos(ang), jnp.sin(ang)


def apply_rope(x, cos, sin):
    b, l, h, d = x.shape
    xr = x.astype(jnp.float32).reshape(b, l, h, 2, 2, ROPE_PAIRS)
    x1, x2 = xr[..., 0, :], xr[..., 1, :]
    cs, sn = cos[None, :, None], sin[None, :, None]
    out = jnp.stack([x1 * cs - x2 * sn, x2 * cs + x1 * sn], axis=-2)
    return out.reshape(b, l, h, d).astype(x.dtype)


def window_attention(q, k, v, k_ctx, v_ctx, sink):
    b, l, h, hd = q.shape
    nb = l // ATT_BLOCK
    qb = q.reshape(b, nb, ATT_BLOCK, ATT_KV_HEADS, ATT_Q_PER_KV, hd)

    def band(t):
        tp = jnp.pad(t, ((0, 0), (ATT_BLOCK, ATT_BLOCK), (0, 0), (0, 0)))
        tp = tp.reshape(b, nb + 2, ATT_BLOCK, ATT_KV_HEADS, hd)
        return jnp.concatenate([tp[:, :-2], tp[:, 1:-1], tp[:, 2:]], axis=2)

    kb, vb = band(k), band(v)
    scale = hd ** -0.5
    s_loc = jnp.einsum("bnqkgd,bnskd->bnkgqs", qb, kb, preferred_element_type=jnp.float32) * scale
    s_ctx = jnp.einsum("bnqkgd,bckd->bnkgqc", qb, k_ctx, preferred_element_type=jnp.float32) * scale
    qi = jnp.arange(nb)[:, None, None] * ATT_BLOCK + jnp.arange(ATT_BLOCK)[None, :, None]
    kj = (jnp.arange(nb)[:, None, None] - 1) * ATT_BLOCK + jnp.arange(3 * ATT_BLOCK)[None, None, :]
    mask = (jnp.abs(qi - kj) <= WINDOW) & (kj >= 0) & (kj < l)
    s_loc = jnp.where(mask[None, :, None, None], s_loc, NEG_INF)
    sink_col = jnp.broadcast_to(
        sink.astype(jnp.float32).reshape(ATT_KV_HEADS, ATT_Q_PER_KV)[None, None, :, :, None, None],
        s_loc.shape[:-1] + (1,))
    p = jax.nn.softmax(jnp.concatenate([sink_col, s_ctx, s_loc], axis=-1), axis=-1)
    c = k_ctx.shape[1]
    o = (jnp.einsum("bnkgqc,bckd->bnqkgd", p[..., 1:1 + c].astype(v.dtype), v_ctx)
         + jnp.einsum("bnkgqs,bnskd->bnqkgd", p[..., 1 + c:].astype(v.dtype), vb))
    return o.reshape(b, l, h * hd)


def context_attention(q, k, v, sink):
    b, c, h, hd = q.shape
    qg = q.reshape(b, c, ATT_KV_HEADS, ATT_Q_PER_KV, hd)
    s = jnp.einsum("bqkgd,bskd->bkgqs", qg, k, preferred_element_type=jnp.float32) * (hd ** -0.5)
    sink_col = jnp.broadcast_to(
        sink.astype(jnp.float32).reshape(ATT_KV_HEADS, ATT_Q_PER_KV)[None, :, :, None, None],
        s.shape[:-1] + (1,))
    p = jax.nn.softmax(jnp.concatenate([sink_col, s], axis=-1), axis=-1)
    o = jnp.einsum("bkgqs,bskd->bqkgd", p[..., 1:].astype(v.dtype), v)
    return o.reshape(b, c, h * hd)


def multiscale_pool(u, w_grp, scale):
    b, l, _ = u.shape
    ug = u.astype(jnp.float32).reshape(b, l, POOL_GROUPS, POOL_GW)
    csum = jnp.pad(jnp.cumsum(ug, axis=1), ((0, 0), (1, 0), (0, 0), (0, 0)))
    t = jnp.arange(l)
    outs = []
    for gi, w in enumerate(POOL_WINDOWS):
        left = w // 2
        right = w - left - 1
        lo = jnp.maximum(t - left, 0)
        hi = jnp.minimum(t + right + 1, l)
        cg = csum[:, :, gi]
        mean = (cg[:, hi] - cg[:, lo]) / (hi - lo).astype(jnp.float32)[None, :, None]
        outs.append(mean - ug[:, :, gi])
    dpool = jnp.stack(outs, axis=2).astype(u.dtype)
    y = jnp.einsum("blgc,gce->blge", dpool, w_grp)
    return y.reshape(b, l, BRANCH_W) * scale


def hyena_filter_spectra(l, w1, b1, f1, w2, b2, f2, w3):
    t01 = jnp.linspace(0.0, 1.0, l, dtype=jnp.float32)
    fr = jnp.linspace(1e-4, HY_BANDS - 1, HY_BANDS, dtype=jnp.float32)
    ang = (2.0 * math.pi / l) * jnp.arange(l, dtype=jnp.float32)[:, None] * fr[None, :]
    feat = jnp.concatenate([t01[:, None], jnp.cos(ang), -jnp.sin(ang)], axis=-1).astype(w1.dtype)
    hdn = jnp.sin(f1 * (feat @ w1 + b1))
    hdn = jnp.sin(f2 * (hdn @ w2 + b2))
    raw = (hdn @ w3).astype(jnp.float32).reshape(l, HY_ORDER, 2, BRANCH_W)
    deltas = jnp.abs(jnp.linspace(math.log(HY_TARGET) / HY_SLOW_PCT, math.log(HY_TARGET) / HY_FAST_PCT,
                                  BRANCH_W, dtype=jnp.float32))
    window = jnp.exp(-t01[:, None] * deltas[None, :]) + HY_MOD_SHIFT
    filt = raw * window[:, None, None, :]
    fwd, bwd = filt[:, :, 0], filt[:, :, 1]
    kern = jnp.concatenate([fwd, jnp.zeros((1, HY_ORDER, BRANCH_W), jnp.float32), bwd[1:][::-1]], axis=0)
    kern = kern * lax.rsqrt(jnp.sum(jnp.square(kern), axis=0, keepdims=True) + LN_EPS)
    return jnp.fft.rfft(kern, axis=0)


def fft_long_conv(z, kern_f):
    l = z.shape[1]
    zf = jnp.fft.rfft(z.astype(jnp.float32), n=2 * l, axis=1)
    y = jnp.fft.irfft(zf * kern_f[None], n=2 * l, axis=1)[:, :l]
    return y.astype(z.dtype)


def hyena_mixer(u, conv_w, conv_b, kern_f, bias):
    uc = conv3_centred(u, conv_w) + conv_b
    x1, x2, v = jnp.split(uc, 3, axis=-1)
    z = v
    for n, gate in enumerate((x1, x2)):
        z = gate * (fft_long_conv(z, kern_f[:, n]) + bias[n] * z)
    return z


def short_conv_mixer(u, conv_w):
    bg, cg, xin = jnp.split(u, 3, axis=-1)
    return bg * conv3_centred(cg * xin, conv_w)


def mix_and_merge(attn_o, pool_in, hy_in, sc_in, gate_logits, lw):
    b, l, _ = attn_o.shape
    y_pool = multiscale_pool(pool_in, lw["pool_w"], lw["pool_scale"])
    kern_f = hyena_filter_spectra(l, lw["hy_w1"], lw["hy_b1"], lw["hy_freq1"], lw["hy_w2"], lw["hy_b2"],
                                  lw["hy_freq2"], lw["hy_w3"])
    y_hy = hyena_mixer(hy_in, lw["hy_conv_w"], lw["hy_conv_b"], kern_f, lw["hy_bias"])
    y_sc = short_conv_mixer(sc_in, lw["sc_conv_w"])
    ys = jnp.stack([attn_o, y_pool.astype(attn_o.dtype), y_hy, y_sc], axis=0)
    br = jnp.einsum("nblc,ncd->nbld", ys, lw["w_branch"])
    gates = jax.nn.sigmoid(gate_logits.reshape(b, l, N_BRANCHES, D_MODEL))
    merged = jnp.einsum("blnd,nbld->bld", gates, br)
    return merged @ lw["w_out"]


def hierarchical_moe(h, rg_w, rg_b, re_w, re_b, w1, w3, w2):
    n, d = h.shape
    lg = (h @ rg_w).astype(jnp.float32) + rg_b.astype(jnp.float32)
    pg = jax.nn.softmax(lg, axis=-1)
    gsel = jnp.argmax(lg, axis=-1).astype(jnp.int32)
    gate_g = jnp.take_along_axis(pg, gsel[:, None], axis=1)[:, 0]
    le = ((h @ re_w).astype(jnp.float32) + re_b.astype(jnp.float32)).reshape(n, N_GROUPS, EXPERTS_PER_GROUP)
    le = jnp.take_along_axis(le, gsel[:, None, None], axis=1)[:, 0]
    top_v, top_i = lax.top_k(le, TOP_K)
    wts = (gate_g[:, None] * jax.nn.softmax(top_v, axis=-1)).reshape(-1)
    eid = (gsel[:, None] * EXPERTS_PER_GROUP + top_i.astype(jnp.int32)).reshape(-1)
    tok = jnp.repeat(jnp.arange(n, dtype=jnp.int32), TOP_K)
    a = n * TOP_K
    order = jnp.argsort(eid)
    e_s, t_s, w_s = eid[order], tok[order], wts[order]
    counts = jnp.bincount(eid, length=N_EXPERTS)
    starts = jnp.cumsum(counts) - counts
    padded = (counts + EXPERT_BLOCK - 1) // EXPERT_BLOCK * EXPERT_BLOCK
    pend = jnp.cumsum(padded)
    pstart = pend - padded
    dest = pstart[e_s] + jnp.arange(a, dtype=jnp.int32) - starts[e_s]
    n_blocks = -(-a // EXPERT_BLOCK) + N_EXPERTS
    slots = n_blocks * EXPERT_BLOCK
    buf_tok = jnp.full((slots,), n, jnp.int32).at[dest].set(t_s)
    buf_w = jnp.zeros((slots,), jnp.float32).at[dest].set(w_s)
    blk_e = jnp.minimum(jnp.searchsorted(pend, jnp.arange(n_blocks, dtype=jnp.int32) * EXPERT_BLOCK, side="right"),
                        N_EXPERTS - 1).astype(jnp.int32)
    xb = jnp.take(h, buf_tok, axis=0, mode="fill", fill_value=0).reshape(n_blocks, EXPERT_BLOCK, d)

    def expert_block(args):
        xblk, e = args
        return (jax.nn.silu(xblk @ w1[e]) * (xblk @ w3[e])) @ w2[e]

    yb = lax.map(expert_block, (xb, blk_e)).reshape(slots, d)
    return jnp.zeros((n, d), h.dtype).at[buf_tok].add(yb * buf_w[:, None].astype(h.dtype), mode="drop")


def setup_inputs(seed: int = 0) -> dict:
    key = jax.random.key(seed)
    ks = iter(jax.random.split(key, 48))

    def nrm(shape, scale):
        return jax.random.normal(next(ks), shape, jnp.float32) * scale

    L = DEPTH
    D = D_MODEL
    return {
        "x": nrm((BATCH, SEQ, D), 1.0),
        "c": nrm((BATCH, D), 1.0),
        "ctx": nrm((BATCH, CTX_LEN, D), 1.0),
        "c_ctx": nrm((D,), 1.0),
        "ada_w": nrm((L, D, 6 * D), D ** -0.5),
        "ada_b": nrm((L, 6 * D), 0.02),
        "w_in": nrm((L, D, IN_COLS), D ** -0.5),
        "attn_sink": nrm((L, ATT_HEADS), 0.5),
        "pool_w": nrm((L, POOL_GROUPS, POOL_GW, POOL_GW), POOL_GW ** -0.5),
        "pool_scale": 1.0 + nrm((L, BRANCH_W), 0.02),
        "hy_conv_w": nrm((L, 3, HY_COLS), 3 ** -0.5),
        "hy_conv_b": nrm((L, HY_COLS), 0.02),
        "hy_w1": nrm((L, HY_EMB, HY_HIDDEN), HY_EMB ** -0.5),
        "hy_b1": nrm((L, HY_HIDDEN), 0.02),
        "hy_freq1": 1.0 + nrm((L, HY_HIDDEN), 0.02),
        "hy_w2": nrm((L, HY_HIDDEN, HY_HIDDEN), HY_HIDDEN ** -0.5),
        "hy_b2": nrm((L, HY_HIDDEN), 0.02),
        "hy_freq2": 1.0 + nrm((L, HY_HIDDEN), 0.02),
        "hy_w3": nrm((L, HY_HIDDEN, HY_FILT_OUT), HY_HIDDEN ** -0.5),
        "hy_bias": nrm((L, HY_ORDER, BRANCH_W), 1.0),
        "sc_conv_w": nrm((L, 3, BRANCH_W), 3 ** -0.5),
        "w_branch": nrm((L, N_BRANCHES, BRANCH_W, D), BRANCH_W ** -0.5),
        "w_out": nrm((L, D, D), DEEPNORM_BETA * D ** -0.5),
        "ln1_g": 1.0 + nrm((L, D), 0.02),
        "ln1_b": nrm((L, D), 0.02),
        "ln2_g": 1.0 + nrm((L, D), 0.02),
        "ln2_b": nrm((L, D), 0.02),
        "rg_w": nrm((L, D, N_GROUPS), D ** -0.5),
        "rg_b": nrm((L, N_GROUPS), 0.01),
        "re_w": nrm((L, D, N_EXPERTS), D ** -0.5),
        "re_b": nrm((L, N_EXPERTS), 0.01),
        "ex_w1": nrm((L, N_EXPERTS, D, EXPERT_HIDDEN), D ** -0.5),
        "ex_w3": nrm((L, N_EXPERTS, D, EXPERT_HIDDEN), D ** -0.5),
        "ex_w2": nrm((L, N_EXPERTS, EXPERT_HIDDEN, D), DEEPNORM_BETA * EXPERT_HIDDEN ** -0.5),
    }


def reference(x, c, ctx, c_ctx, ada_w, ada_b, w_in, attn_sink, pool_w, pool_scale, hy_conv_w, hy_conv_b,
              hy_w1, hy_b1, hy_freq1, hy_w2, hy_b2, hy_freq2, hy_w3, hy_bias, sc_conv_w, w_branch, w_out,
              ln1_g, ln1_b, ln2_g, ln2_b, rg_w, rg_b, re_w, re_b, ex_w1, ex_w3, ex_w2):
    b, l, d = x.shape
    cl = ctx.shape[1]
    rows = l // GRID_W
    cos, sin = axial_rope_tables(rows)
    xc = ctx
    silu_c = jax.nn.silu(c)
    silu_cc = jax.nn.silu(c_ctx)
    for i in range(DEPTH):
        last = i == DEPTH - 1
        lw = {"pool_w": pool_w[i], "pool_scale": pool_scale[i], "hy_conv_w": hy_conv_w[i],
              "hy_conv_b": hy_conv_b[i], "hy_w1": hy_w1[i], "hy_b1": hy_b1[i], "hy_freq1": hy_freq1[i],
              "hy_w2": hy_w2[i], "hy_b2": hy_b2[i], "hy_freq2": hy_freq2[i], "hy_w3": hy_w3[i],
              "hy_bias": hy_bias[i], "sc_conv_w": sc_conv_w[i], "w_branch": w_branch[i], "w_out": w_out[i]}
        mod_l = (silu_c @ ada_w[i] + ada_b[i])[:, None, :]
        mod_c = silu_cc @ ada_w[i] + ada_b[i]
        sh1_l, sc1_l, g1_l, sh2_l, sc2_l, g2_l = jnp.split(mod_l, 6, axis=-1)
        sh1_c, sc1_c, g1_c, sh2_c, sc2_c, g2_c = jnp.split(mod_c, 6, axis=-1)

        hc_in = modulate(xc, sh1_c, sc1_c)
        if last:
            kv_c = hc_in @ w_in[i][:, Q_COLS:Q_COLS + 2 * KV_COLS]
            kc, vc = jnp.split(kv_c, 2, axis=-1)
        else:
            qc, kc, vc, pool_c, hy_c, sc_c, gate_c = split_cols(hc_in @ w_in[i])
        kc = kc.reshape(b, cl, ATT_KV_HEADS, HEAD_DIM)
        vc = vc.reshape(b, cl, ATT_KV_HEADS, HEAD_DIM)

        ql, kl, vl, pool_l, hy_l, sc_l, gate_l = split_cols(modulate(x, sh1_l, sc1_l) @ w_in[i])
        ql = apply_rope(ql.reshape(b, l, ATT_HEADS, HEAD_DIM), cos, sin)
        kl = apply_rope(kl.reshape(b, l, ATT_KV_HEADS, HEAD_DIM), cos, sin)
        vl = vl.reshape(b, l, ATT_KV_HEADS, HEAD_DIM)
        att_l = window_attention(ql, kl, vl, kc, vc, attn_sink[i])
        y_l = mix_and_merge(att_l, pool_l, hy_l, sc_l, gate_l, lw)
        x = layer_norm_affine(DEEPNORM_ALPHA * x + g1_l * y_l, ln1_g[i], ln1_b[i])
        if not last:
            att_c = context_attention(qc.reshape(b, cl, ATT_HEADS, HEAD_DIM), kc, vc, attn_sink[i])
            y_c = mix_and_merge(att_c, pool_c, hy_c, sc_c, gate_c, lw)
            xc = layer_norm_affine(DEEPNORM_ALPHA * xc + g1_c * y_c, ln1_g[i], ln1_b[i])

        m_l = modulate(x, sh2_l, sc2_l).reshape(b * l, d)
        if last:
            f_l = hierarchical_moe(m_l, rg_w[i], rg_b[i], re_w[i], re_b[i], ex_w1[i], ex_w3[i], ex_w2[i])
        else:
            m_c = modulate(xc, sh2_c, sc2_c).reshape(b * cl, d)
            f_all = hierarchical_moe(jnp.concatenate([m_c, m_l], axis=0), rg_w[i], rg_b[i], re_w[i], re_b[i],
                                     ex_w1[i], ex_w3[i], ex_w2[i])
            f_c, f_l = f_all[:b * cl], f_all[b * cl:]
            xc = layer_norm_affine(DEEPNORM_ALPHA * xc + g2_c * f_c.reshape(b, cl, d), ln2_g[i], ln2_b[i])
        x = layer_norm_affine(DEEPNORM_ALPHA * x + g2_l * f_l.reshape(b, l, d), ln2_g[i], ln2_b[i])
    return x
```

```cpp
#include <hip/hip_runtime.h>
#include <cstdio>
#include <cstdint>

#define GAS __attribute__((address_space(1)))
#define LAS __attribute__((address_space(3)))
typedef unsigned short bf16;
typedef float f32x4 __attribute__((ext_vector_type(4)));
typedef float f32x2 __attribute__((ext_vector_type(2)));
typedef float f32x16 __attribute__((ext_vector_type(16)));
typedef unsigned u32x4 __attribute__((ext_vector_type(4)));
typedef unsigned u32x2 __attribute__((ext_vector_type(2)));
typedef short bf16x8 __attribute__((ext_vector_type(8)));
typedef short s16x4 __attribute__((ext_vector_type(4)));
typedef __bf16 bf16x2_t __attribute__((ext_vector_type(2)));

constexpr int ML = 16384, MC = 256, MT = ML + MC, DM = 1024, NLAYER = 4;
constexpr int NPANEL = MT / 256;
constexpr int INCOLS = 8448;
constexpr int SMAXP = 162;
constexpr float DN_ALPHA = 1.681792830507429f;
constexpr float LN_EPS = 1e-6f;
constexpr float QSCALE = 0.125f * 1.4426950408889634f;
constexpr float LOG2E = 1.4426950408889634f;

constexpr size_t MiB = 1u << 20;
constexpr size_t WS_CTL = 0, CTL_ZERO_BYTES = 1 * MiB;
constexpr size_t WS_MOD = 1 * MiB;
constexpr size_t WS_ROPE = 1 * MiB + 256 * 1024;
constexpr size_t WS_HDN2C = 1 * MiB + 512 * 1024;
constexpr size_t WS_WGCNT = 1 * MiB + 768 * 1024;
constexpr size_t WS_PANEL = 1 * MiB + 832 * 1024;
constexpr size_t WS_TOKREC = 2 * MiB;
constexpr size_t WS_TOKSLOT = 3 * MiB;
constexpr size_t WS_ROWTOK = 3 * MiB + 512 * 1024;
constexpr size_t WS_W3T = 4 * MiB;
constexpr size_t WS_HDN2B = 8 * MiB;
constexpr size_t WS_WIN = 40 * MiB;
constexpr size_t WS_WBR = 57 * MiB;
constexpr size_t WS_WOUT = 61 * MiB;
constexpr size_t WS_W13 = 64 * MiB;
constexpr size_t WS_W2 = 128 * MiB;
constexpr size_t WS_TAPS = 160 * MiB;
constexpr size_t WS_KSPEC = 224 * MiB;
constexpr size_t WS_X = 352 * MiB;
constexpr size_t WS_T1 = 417 * MiB;
constexpr size_t WS_XN = 482 * MiB;
constexpr size_t WS_HN = 515 * MiB;
constexpr size_t WS_R1 = 548 * MiB;
constexpr size_t SZ_Q = (size_t)MT * 512 * 2, SZ_KV = (size_t)MT * 128 * 2, SZ_HY = (size_t)MT * 1536 * 2, SZ_GATE = (size_t)MT * 4096 * 2;
constexpr size_t WS_Q = WS_R1, WS_K = WS_Q + SZ_Q, WS_V = WS_K + SZ_KV, WS_POOL = WS_V + SZ_KV, WS_HY = WS_POOL + SZ_Q, WS_SC = WS_HY + SZ_HY, WS_GATE = WS_SC + SZ_HY;
constexpr size_t WS_ASORT = WS_R1, WS_HS = WS_R1 + 81 * MiB, WS_YS = WS_R1 + 122 * MiB;
constexpr size_t WS_ABR = 817 * MiB;
constexpr size_t WS_HT = 882 * MiB;
constexpr size_t WS_HTC = 930 * MiB;
constexpr size_t WS_YHT = 931 * MiB;
constexpr size_t WS_MERGED = 947 * MiB;
constexpr size_t WS_END = 980 * MiB;
static_assert(WS_GATE + SZ_GATE <= WS_ABR && WS_YS + (size_t)SMAXP * 256 * 1024 * 2 <= WS_ABR && WS_HS + (size_t)SMAXP * 256 * 512 * 2 <= WS_YS && (size_t)SMAXP * 256 * 1024 * 2 <= 81 * MiB, "ws map");
constexpr int CW_BAR = 4096;

constexpr int LDS_BYTES = 163840;
constexpr int MISC_OFF = 161792;
constexpr int NWAVES = 8;

__device__ __forceinline__ unsigned f2bf(float f) { unsigned u = __builtin_bit_cast(unsigned, f); return (u + 0x7fffu + ((u >> 16) & 1u)) >> 16; }
__device__ __forceinline__ unsigned pk2(float lo, float hi) { bf16x2_t b = __builtin_convertvector((f32x2){lo, hi}, bf16x2_t); return __builtin_bit_cast(unsigned, b); }
__device__ __forceinline__ float bf2f(unsigned u) { return __builtin_bit_cast(float, u << 16); }
__device__ __forceinline__ float bflo(unsigned u) { return __builtin_bit_cast(float, u << 16); }
__device__ __forceinline__ float bfhi(unsigned u) { return __builtin_bit_cast(float, u & 0xffff0000u); }
__device__ __forceinline__ float wave_sum(float v) {
#define WS_DPP(x, ctrl, rmask) __builtin_bit_cast(float, __builtin_amdgcn_update_dpp(0, __builtin_bit_cast(int, x), ctrl, rmask, 0xf, false))
    v += WS_DPP(v, 0x111, 0xf);
    v += WS_DPP(v, 0x112, 0xf);
    v += WS_DPP(v, 0x114, 0xf);
    v += WS_DPP(v, 0x118, 0xf);
    v += WS_DPP(v, 0x142, 0xa);
    v += WS_DPP(v, 0x143, 0xc);
#undef WS_DPP
    return __builtin_bit_cast(float, __builtin_amdgcn_readlane(__builtin_bit_cast(int, v), 63));
}
#define LDS_WAIT() asm volatile("s_waitcnt lgkmcnt(0)" ::: "memory")
#define VM_WAIT() asm volatile("s_waitcnt vmcnt(0)" ::: "memory")

namespace pg8 {
#define PG8_LAS __attribute__((address_space(3)))
typedef unsigned short bf16_t;
typedef short bf16x8 __attribute__((ext_vector_type(8)));
typedef float f32x4 __attribute__((ext_vector_type(4)));
typedef unsigned u32x4 __attribute__((ext_vector_type(4)));
constexpr int BM = 256, BK = 64, HALF = 128, HTB = HALF * BK * 2  , STAGE_BYTES = 8 * HTB, NXCD = 8, WGM = 8;

__host__ __device__ __forceinline__ int lds_byte(int r, int c) { const int st = (r >> 4) * 2 + (c >> 5), rr = r & 15, cc = c & 31, ob = rr * 64 + cc * 2; return st * 1024 + (ob ^ (((ob >> 9) & 1) << 5)); }
__host__ __device__ __forceinline__ void stage_rc(int b, int& R, int& C) { const int st = b / 1024, sb = b % 1024, swz = sb ^ (((sb >> 9) & 1) << 5); R = (st >> 1) * 16 + swz / 64; C = (st & 1) * 32 + (swz % 64) / 2; }
__host__ __device__ __forceinline__ int perm32(int rho) { const int n = rho >> 4, i = rho & 15; return 8 * (i >> 2) + 4 * n + (i & 3); }

struct Unit { int pm, pn; };
struct Gemm { const bf16_t* A; const bf16_t* Bt; int M, N, K; };

struct StaticOrder {
    int nM, nN, nwg, G, c;
    __host__ __device__ void init(int M, int N, int G_, int c_) { nM = M / BM; nN = N / BM; nwg = nM * nN; G = G_; c = c_; }
    __host__ __device__ bool next(int i, Unit& u) const {
        const long L = (long)i * G + c; if (L >= nwg) return false;
        int wgid = (int)L; { const int q = nwg / NXCD, r = nwg % NXCD, xcd = wgid % NXCD, off = wgid / NXCD; wgid = (xcd < r ? xcd * (q + 1) : r * (q + 1) + (xcd - r) * q) + off; }
        const int nig = WGM * nN, gid = wgid / nig, fm = gid * WGM, gsz = (nM - fm) < WGM ? (nM - fm) : WGM;
        u.pm = fm + ((wgid % nig) % gsz); u.pn = (wgid % nig) / gsz; return true;
    }
    __device__ __forceinline__ void a_ready(const Unit&) const {}
    __device__ __forceinline__ void done(const Unit&) const {}
};
__device__ __forceinline__ unsigned cvt_pk_bf16(float lo, float hi) { unsigned r; asm volatile("v_cvt_pk_bf16_f32 %0, %1, %2" : "=v"(r) : "v"(lo), "v"(hi)); return r; }
typedef float f32x2 __attribute__((ext_vector_type(2)));
constexpr float DN_ALPHA_C = 1.681792830507429f;
typedef GAS u32x4 gv4u; typedef GAS f32x4 gv4f; typedef GAS u32x2 gv2u;
struct EpiBase { static constexpr bool PERM = true, AFTER_DRAIN = false; __device__ __forceinline__ bool keep(const Unit&) const { return false; } };

struct EpiInProj : EpiBase {
    bf16_t *Q, *K, *V, *POOL, *HY, *SC, *GATE; const float* rcos; const float* rsin; int n_lat; float qscale;
    __device__ __forceinline__ void operator()(f32x4 (&acc)[2][2][4][2], const Unit& u, int wr, int wc, int fr, int fq) const {
        const int row0 = u.pm * BM + wr * 64 + fr;
#pragma unroll
        for (int bj = 0; bj < 2; ++bj) {
            const int ctile = u.pn * BM + bj * HALF;
            bf16_t* base; int ld, coff, mode = 0;
            if (ctile < 512) { base = Q; ld = 512; coff = ctile; mode = 1; }
            else if (ctile < 640) { base = K; ld = 128; coff = ctile - 512; mode = 2; }
            else if (ctile < 768) { base = V; ld = 128; coff = ctile - 640; }
            else if (ctile < 1280) { base = POOL; ld = 512; coff = ctile - 768; }
            else if (ctile < 2816) { base = HY; ld = 1536; coff = ctile - 1280; }
            else if (ctile < 4352) { base = SC; ld = 1536; coff = ctile - 2816; }
            else { base = GATE; ld = 4096; coff = ctile - 4352; }
            const int col = coff + wc * 32 + 8 * fq;
#pragma unroll
            for (int ai = 0; ai < 2; ++ai)
#pragma unroll
                for (int m = 0; m < 4; ++m) {
                    const int row = row0 + ai * HALF + m * 16;
                    f32x4 v0 = acc[ai][bj][m][0], v1 = acc[ai][bj][m][1];
                    if (mode) {
                        if (row < n_lat) {
                            const int pidx = (wc & 1) ? 256 + (row & 63) : (row >> 6);
                            const f32x4 c4 = *(const gv4f*)(rcos + pidx * 16 + 4 * fq), s4 = *(const gv4f*)(rsin + pidx * 16 + 4 * fq);
                            f32x4 a, b;
                            a.x = v0.x * c4.x - v0.y * s4.x; a.y = v0.y * c4.x + v0.x * s4.x; a.z = v0.z * c4.y - v0.w * s4.y; a.w = v0.w * c4.y + v0.z * s4.y;
                            b.x = v1.x * c4.z - v1.y * s4.z; b.y = v1.y * c4.z + v1.x * s4.z; b.z = v1.z * c4.w - v1.w * s4.w; b.w = v1.w * c4.w + v1.z * s4.w;
                            v0 = a; v1 = b;
                        }
                        if (mode == 1) { v0 = v0 * qscale; v1 = v1 * qscale; }
                    }
                    if (ctile >= 4352) {
#pragma unroll
                        for (int e_ = 0; e_ < 4; ++e_) { v0[e_] = __builtin_amdgcn_rcpf(1.f + __expf(-fminf(fmaxf(v0[e_], -30.f), 30.f))); v1[e_] = __builtin_amdgcn_rcpf(1.f + __expf(-fminf(fmaxf(v1[e_], -30.f), 30.f))); }
                    }
                    u32x4 w; w.x = cvt_pk_bf16(v0[0], v0[1]); w.y = cvt_pk_bf16(v0[2], v0[3]); w.z = cvt_pk_bf16(v1[0], v1[1]); w.w = cvt_pk_bf16(v1[2], v1[3]);
                    *(gv4u*)(base + (size_t)row * ld + col) = w;
                }
        }
    }
};
struct EpiPlain : EpiBase {
    bf16_t* O; int ldc;
    __device__ __forceinline__ void operator()(f32x4 (&acc)[2][2][4][2], const Unit& u, int wr, int wc, int fr, int fq) const {
        const int row0 = u.pm * BM + wr * 64 + fr, col0 = u.pn * BM + wc * 32 + 8 * fq;
#pragma unroll
        for (int ai = 0; ai < 2; ++ai)
#pragma unroll
            for (int m = 0; m < 4; ++m)
#pragma unroll
                for (int bj = 0; bj < 2; ++bj) {
                    const f32x4 v0 = acc[ai][bj][m][0], v1 = acc[ai][bj][m][1];
                    u32x4 w; w.x = cvt_pk_bf16(v0[0], v0[1]); w.y = cvt_pk_bf16(v0[2], v0[3]); w.z = cvt_pk_bf16(v1[0], v1[1]); w.w = cvt_pk_bf16(v1[2], v1[3]);
                    *(gv4u*)(O + (size_t)(row0 + ai * HALF + m * 16) * ldc + col0 + bj * HALF) = w;
                }
    }
};
struct EpiBranch {
    static constexpr bool PERM = true, AFTER_DRAIN = false;
    const bf16_t* GATE; bf16_t* MERGED; int npan;
    __device__ __forceinline__ bool keep(const Unit& u) const { return (u.pn >> 2) < 3; }
    __device__ __forceinline__ void operator()(f32x4 (&acc)[2][2][4][2], const Unit& u, int wr, int wc, int fr, int fq) const {
        const int n = u.pn >> 2, pnl = u.pn & 3, pm = u.pm - n * npan;
        const int row0 = pm * BM + wr * 64 + fr, col0 = pnl * BM + wc * 32 + 8 * fq;
#pragma unroll
        for (int ai = 0; ai < 2; ++ai) {
            u32x4 ga[4][2], gb[4][2];
#pragma unroll
            for (int m = 0; m < 4; ++m)
#pragma unroll
                for (int bj = 0; bj < 2; ++bj) { const bf16_t* gp = GATE + (size_t)(row0 + ai * HALF + m * 16) * 4096 + n * 1024 + col0 + bj * HALF;
                    ga[m][bj] = *(const gv4u*)gp; if (n < 3) gb[m][bj] = *(const gv4u*)(gp + 1024); else gb[m][bj] = ga[m][bj]; }
            __builtin_amdgcn_sched_barrier(0);
#pragma unroll
            for (int m = 0; m < 4; ++m)
#pragma unroll
                for (int bj = 0; bj < 2; ++bj) {
                    const int row = row0 + ai * HALF + m * 16, col = col0 + bj * HALF;
                    float sa[8];
#pragma unroll
                    for (int i = 0; i < 4; ++i) { const unsigned w = ga[m][bj][i]; sa[2 * i] = __builtin_bit_cast(float, w << 16); sa[2 * i + 1] = __builtin_bit_cast(float, w & 0xffff0000u); }
                    if (n < 3) {
                        float r[8];
#pragma unroll
                        for (int i = 0; i < 4; ++i) { const unsigned w = gb[m][bj][i]; r[2 * i] = sa[2 * i] * __builtin_amdgcn_rcpf(__builtin_bit_cast(float, w << 16)); r[2 * i + 1] = sa[2 * i + 1] * __builtin_amdgcn_rcpf(__builtin_bit_cast(float, w & 0xffff0000u)); }
                        f32x4& v0 = acc[ai][bj][m][0]; f32x4& v1 = acc[ai][bj][m][1];
                        v0.x *= r[0]; v0.y *= r[1]; v0.z *= r[2]; v0.w *= r[3]; v1.x *= r[4]; v1.y *= r[5]; v1.z *= r[6]; v1.w *= r[7];
                    } else {
                        const f32x4 v0 = acc[ai][bj][m][0], v1 = acc[ai][bj][m][1];
                        u32x4 w; w.x = cvt_pk_bf16(v0[0] * sa[0], v0[1] * sa[1]); w.y = cvt_pk_bf16(v0[2] * sa[2], v0[3] * sa[3]);
                        w.z = cvt_pk_bf16(v1[0] * sa[4], v1[1] * sa[5]); w.w = cvt_pk_bf16(v1[2] * sa[6], v1[3] * sa[7]);
                        *(gv4u*)(MERGED + (size_t)row * 1024 + col) = w;
                    }
                }
        }
    }
};
struct EpiOut : EpiBase {
    const float* xf; const bf16_t* xb; const float* g1l; bf16_t* T1;
    __device__ __forceinline__ void operator()(f32x4 (&acc)[2][2][4][2], const Unit& u, int wr, int wc, int fr, int fq) const {
        const int row0 = u.pm * BM + wr * 64 + fr, col0 = u.pn * BM + wc * 32 + 8 * fq;
#pragma unroll
        for (int bj = 0; bj < 2; ++bj) {
            const int col = col0 + bj * HALF;
            const f32x4 ga = *(const gv4f*)(g1l + col), gb = *(const gv4f*)(g1l + col + 4);
#pragma unroll
            for (int ai = 0; ai < 2; ++ai) {
                f32x4 xa[4], xc[4];
                if (xf) {
#pragma unroll
                    for (int m = 0; m < 4; ++m) { const size_t o = (size_t)(row0 + ai * HALF + m * 16) * 1024 + col; xa[m] = *(const gv4f*)(xf + o); xc[m] = *(const gv4f*)(xf + o + 4); }
                } else {
                    u32x4 w[4];
#pragma unroll
                    for (int m = 0; m < 4; ++m) w[m] = *(const gv4u*)(xb + (size_t)(row0 + ai * HALF + m * 16) * 1024 + col);
#pragma unroll
                    for (int m = 0; m < 4; ++m) {
                        xa[m].x = __builtin_bit_cast(float, w[m].x << 16); xa[m].y = __builtin_bit_cast(float, w[m].x & 0xffff0000u); xa[m].z = __builtin_bit_cast(float, w[m].y << 16); xa[m].w = __builtin_bit_cast(float, w[m].y & 0xffff0000u);
                        xc[m].x = __builtin_bit_cast(float, w[m].z << 16); xc[m].y = __builtin_bit_cast(float, w[m].z & 0xffff0000u); xc[m].z = __builtin_bit_cast(float, w[m].w << 16); xc[m].w = __builtin_bit_cast(float, w[m].w & 0xffff0000u); }
                }
                __builtin_amdgcn_sched_barrier(0);
#pragma unroll
                for (int m = 0; m < 4; ++m) {
                    const int row = row0 + ai * HALF + m * 16;
                    const f32x4 oa = xa[m] * DN_ALPHA_C + ga * acc[ai][bj][m][0], ob = xc[m] * DN_ALPHA_C + gb * acc[ai][bj][m][1];
                    u32x4 o; o.x = cvt_pk_bf16(oa[0], oa[1]); o.y = cvt_pk_bf16(oa[2], oa[3]); o.z = cvt_pk_bf16(ob[0], ob[1]); o.w = cvt_pk_bf16(ob[2], ob[3]);
                    *(gv4u*)(T1 + (size_t)row * 1024 + col) = o;
                }
            }
        }
    }
};
struct EpiE1 : EpiBase {
    bf16_t* H;
    __device__ __forceinline__ void operator()(f32x4 (&acc)[2][2][4][2], const Unit& u, int wr, int wc, int fr, int fq) const {
        const int pnl = u.pn & 3, row0 = u.pm * BM + wr * 64 + fr, hc0 = pnl * 128 + wc * 16 + 4 * fq;
#pragma unroll
        for (int ai = 0; ai < 2; ++ai)
#pragma unroll
            for (int m = 0; m < 4; ++m)
#pragma unroll
                for (int bj = 0; bj < 2; ++bj) {
                    const f32x4 v0 = acc[ai][bj][m][0], v1 = acc[ai][bj][m][1];
                    const float h0 = v0.x * __builtin_amdgcn_rcpf(1.f + __expf(-v0.x)) * v0.y, h1 = v0.z * __builtin_amdgcn_rcpf(1.f + __expf(-v0.z)) * v0.w;
                    const float h2 = v1.x * __builtin_amdgcn_rcpf(1.f + __expf(-v1.x)) * v1.y, h3 = v1.z * __builtin_amdgcn_rcpf(1.f + __expf(-v1.z)) * v1.w;
                    u32x2 w; w.x = cvt_pk_bf16(h0, h1); w.y = cvt_pk_bf16(h2, h3);
                    *(gv2u*)(H + (size_t)(row0 + ai * HALF + m * 16) * 512 + hc0 + bj * 64) = w;
                }
    }
};
struct EpiE2 : EpiBase {
    bf16_t* Y;
    __device__ __forceinline__ void operator()(f32x4 (&acc)[2][2][4][2], const Unit& u, int wr, int wc, int fr, int fq) const {
        const int pnl = u.pn & 3, row0 = u.pm * BM + wr * 64 + fr, col0 = pnl * BM + wc * 32 + 8 * fq;
#pragma unroll
        for (int ai = 0; ai < 2; ++ai)
#pragma unroll
            for (int m = 0; m < 4; ++m)
#pragma unroll
                for (int bj = 0; bj < 2; ++bj) {
                    const f32x4 v0 = acc[ai][bj][m][0], v1 = acc[ai][bj][m][1];
                    u32x4 w; w.x = cvt_pk_bf16(v0[0], v0[1]); w.y = cvt_pk_bf16(v0[2], v0[3]); w.z = cvt_pk_bf16(v1[0], v1[1]); w.w = cvt_pk_bf16(v1[2], v1[3]);
                    *(gv4u*)(Y + (size_t)(row0 + ai * HALF + m * 16) * 1024 + col0 + bj * HALF) = w;
                }
    }
};
struct HooksNone { __device__ __forceinline__ void a_ready(const Unit&) const {} __device__ __forceinline__ void done(const Unit&) const {} };
struct BranchOrder : HooksNone {
    int G, c, ntile, npan;
    __device__ __forceinline__ bool next(int i, Unit& u) const { const int T = (i >> 2) * G + c; if (T >= ntile) return false; const int n = i & 3; u.pm = n * npan + (T >> 2); u.pn = n * 4 + (T & 3); return true; }
};
struct ExpertOrder : HooksNone {
    int G, c; const int* panel_e; int npanels;
    __device__ __forceinline__ bool next(int i, Unit& u) const { const int L = i * G + c; if (L >= npanels * 4) return false; const int p = L >> 2; u.pm = p; u.pn = panel_e[p] * 4 + (L & 3); return true; }
};
template <class Epi, class Sched, bool ALIGN_EPI = false, bool SP2 = false>
__device__ __forceinline__ void gemm_phase(PG8_LAS unsigned char* lds, const Gemm g, const Sched& S, const Epi& E) {
    int tid_ = threadIdx.x; asm volatile("" : "+v"(tid_));
    const int tid = tid_, wid = __builtin_amdgcn_readfirstlane(tid >> 6), lane = tid & 63, wr = wid >> 2, wc = wid & 3, fr = lane & 15, fq = lane >> 4;
    const int K = g.K, nt = K / BK;
    unsigned voffA[2], voffB[2];
#pragma unroll
    for (int i = 0; i < 2; ++i) { int R, C; stage_rc(tid * 16 + i * 8192, R, C); const int Rb = Epi::PERM ? ((R & ~31) + perm32(R & 31)) : R;
        voffA[i] = (unsigned)(R * K + C) * 2u; voffB[i] = (unsigned)(Rb * K + C) * 2u; }
    const size_t kstep = (size_t)(BK * 2);
    const size_t hstep = (size_t)HALF * K * 2;
    const size_t tstep = 2 * hstep;
    const unsigned ldsw = (unsigned)wid * 1024u;
    const int aoff = lds_byte(wr * 64 + fr, fq * 8), boff = lds_byte(wc * 32 + fr, fq * 8);
#define PG8_SA(b, h) (((b) * 2 + (h)) * HTB)
#define PG8_SB(b, h) ((4 + (b) * 2 + (h)) * HTB)
#define PG8_STAGE(bufoff, gbase, voff) do { _Pragma("unroll") for (int _i = 0; _i < 2; ++_i) \
        __builtin_amdgcn_global_load_lds((const unsigned*)((const char*)(gbase) + (voff)[_i]), (PG8_LAS unsigned*)(lds + (bufoff) + ldsw + _i * 8192), 16, 0, 0); } while (0)
#define PG8_LDA(dst, b, h) do { _Pragma("unroll") for (int m = 0; m < 4; ++m) _Pragma("unroll") for (int k = 0; k < 2; ++k) dst[m][k] = *(const PG8_LAS bf16x8*)(lds + PG8_SA(b, h) + aoff + m * 2048 + k * 1024); } while (0)
#define PG8_LDB(dst, b, h) do { _Pragma("unroll") for (int n = 0; n < 2; ++n) _Pragma("unroll") for (int k = 0; k < 2; ++k) dst[n][k] = *(const PG8_LAS bf16x8*)(lds + PG8_SB(b, h) + boff + n * 2048 + k * 1024); } while (0)
#define PG8_MMA(ai, bj, At, Bt) do { __builtin_amdgcn_s_setprio(1); _Pragma("unroll") for (int m = 0; m < 4; ++m) _Pragma("unroll") for (int n = 0; n < 2; ++n) _Pragma("unroll") for (int k = 0; k < 2; ++k) \
        acc[ai][bj][m][n] = __builtin_amdgcn_mfma_f32_16x16x32_bf16(Bt[n][k], At[m][k], acc[ai][bj][m][n], 0, 0, 0); __builtin_amdgcn_s_setprio(0); } while (0)
#define PG8_WAIT_V(n) asm volatile("s_waitcnt vmcnt(" #n ")" ::: "memory")
#define PG8_WAIT_L(n) asm volatile("s_waitcnt lgkmcnt(" #n ")" ::: "memory")
#define PG8_BAR __builtin_amdgcn_s_barrier()
#define PG8_SCHED __builtin_amdgcn_sched_barrier(0)
    Unit cur, nxt; int ui = 0;
    if (!S.next(0, cur)) return;
    f32x4 acc[2][2][4][2];
#pragma unroll
    for (int a = 0; a < 2; ++a)
#pragma unroll
        for (int b = 0; b < 2; ++b)
#pragma unroll
            for (int m = 0; m < 4; ++m)
#pragma unroll
                for (int n = 0; n < 2; ++n) acc[a][b][m][n] = (f32x4){0.f, 0.f, 0.f, 0.f};
    bf16x8 At[4][2], B0[2][2], B1[2][2];
    const char* cA = (const char*)g.A + (size_t)cur.pm * tstep; const char* cB = (const char*)g.Bt + (size_t)cur.pn * tstep;
    S.a_ready(cur);
    if constexpr (SP2) {
        PG8_STAGE(PG8_SB(0, 0), cB, voffB); PG8_STAGE(PG8_SB(0, 1), cB + hstep, voffB); PG8_STAGE(PG8_SA(0, 0), cA, voffA); PG8_STAGE(PG8_SA(0, 1), cA + hstep, voffA);
        if (wr == 1) PG8_BAR;
        PG8_WAIT_V(2); PG8_BAR;
        PG8_STAGE(PG8_SB(1, 0), cB + kstep, voffB); PG8_STAGE(PG8_SA(1, 0), cA + kstep, voffA); PG8_STAGE(PG8_SB(1, 1), cB + hstep + kstep, voffB);
        PG8_WAIT_V(6); PG8_BAR;
    } else {
        PG8_STAGE(PG8_SB(0, 0), cB, voffB); PG8_STAGE(PG8_SA(0, 0), cA, voffA); PG8_STAGE(PG8_SB(0, 1), cB + hstep, voffB); PG8_STAGE(PG8_SA(0, 1), cA + hstep, voffA);
        if (wr == 1) PG8_BAR;
        PG8_WAIT_V(4); PG8_BAR;
        PG8_STAGE(PG8_SB(1, 0), cB + kstep, voffB); PG8_STAGE(PG8_SA(1, 0), cA + kstep, voffA); PG8_STAGE(PG8_SB(1, 1), cB + hstep + kstep, voffB);
        PG8_WAIT_V(6); PG8_BAR;
    }
    for (;;) {
        const bool has_next = S.next(ui + 1, nxt);
        const char* nA = has_next ? (const char*)g.A + (size_t)nxt.pm * tstep : cA; const char* nB = has_next ? (const char*)g.Bt + (size_t)nxt.pn * tstep : cB;
#pragma unroll 1
        for (int t = 0; t < nt; t += 2) {
            const bool last = (t == nt - 2);
            const char* a1 = cA + (size_t)(t + 1) * kstep;
            const char* a2 = last ? nA : cA + (size_t)(t + 2) * kstep; const char* b2 = last ? nB : cB + (size_t)(t + 2) * kstep;
            const char* a3 = a2 + kstep; const char* b3 = b2 + kstep;
            if (last && has_next) S.a_ready(nxt);
            if constexpr (SP2) {
            PG8_LDB(B0, 0, 0); PG8_LDB(B1, 0, 1); PG8_SCHED; PG8_LDA(At, 0, 0); PG8_STAGE(PG8_SA(1, 1), a1 + hstep, voffA);
            PG8_WAIT_V(8); PG8_WAIT_L(0); PG8_BAR; PG8_MMA(0, 0, At, B0); PG8_MMA(0, 1, At, B1); PG8_BAR; PG8_SCHED;
            PG8_LDA(At, 0, 1); PG8_STAGE(PG8_SB(0, 0), b2, voffB); PG8_STAGE(PG8_SB(0, 1), b2 + hstep, voffB); PG8_STAGE(PG8_SA(0, 0), a2, voffA);
            PG8_WAIT_V(8); PG8_WAIT_L(0); PG8_BAR; PG8_MMA(1, 0, At, B0); PG8_MMA(1, 1, At, B1); PG8_BAR; PG8_SCHED;
            PG8_LDB(B0, 1, 0); PG8_LDB(B1, 1, 1); PG8_SCHED; PG8_LDA(At, 1, 0); PG8_STAGE(PG8_SA(0, 1), a2 + hstep, voffA);
            PG8_WAIT_V(8); PG8_WAIT_L(0); PG8_BAR; PG8_MMA(0, 0, At, B0); PG8_MMA(0, 1, At, B1); PG8_BAR; PG8_SCHED;
            PG8_LDA(At, 1, 1); PG8_STAGE(PG8_SB(1, 0), b3, voffB); PG8_STAGE(PG8_SB(1, 1), b3 + hstep, voffB); PG8_STAGE(PG8_SA(1, 0), a3, voffA);
            PG8_WAIT_V(8); PG8_WAIT_L(0); PG8_BAR; PG8_MMA(1, 0, At, B0); PG8_MMA(1, 1, At, B1); PG8_BAR; PG8_SCHED;
            } else {
            PG8_LDB(B0, 0, 0); PG8_SCHED; PG8_LDA(At, 0, 0); PG8_STAGE(PG8_SA(1, 1), a1 + hstep, voffA);
            PG8_WAIT_L(8); PG8_BAR; PG8_WAIT_L(0); PG8_MMA(0, 0, At, B0); PG8_BAR; PG8_SCHED;
            PG8_LDB(B1, 0, 1); PG8_STAGE(PG8_SB(0, 0), b2, voffB);
            PG8_BAR; PG8_WAIT_L(0); PG8_MMA(0, 1, At, B1); PG8_BAR;
            PG8_LDA(At, 0, 1); PG8_STAGE(PG8_SA(0, 0), a2, voffA);
            PG8_BAR; PG8_WAIT_L(0); PG8_MMA(1, 0, At, B0); PG8_BAR; PG8_SCHED;
            PG8_STAGE(PG8_SB(0, 1), b2 + hstep, voffB);
            PG8_WAIT_V(6); PG8_BAR; PG8_MMA(1, 1, At, B1); PG8_BAR;
            PG8_LDB(B0, 1, 0); PG8_SCHED; PG8_LDA(At, 1, 0); PG8_STAGE(PG8_SA(0, 1), a2 + hstep, voffA);
            PG8_WAIT_L(8); PG8_BAR; PG8_WAIT_L(0); PG8_MMA(0, 0, At, B0); PG8_BAR; PG8_SCHED;
            PG8_LDB(B1, 1, 1); PG8_STAGE(PG8_SB(1, 0), b3, voffB);
            PG8_BAR; PG8_WAIT_L(0); PG8_MMA(0, 1, At, B1); PG8_BAR;
            PG8_LDA(At, 1, 1); PG8_STAGE(PG8_SA(1, 0), a3, voffA);
            PG8_BAR; PG8_WAIT_L(0); PG8_MMA(1, 0, At, B0); PG8_BAR; PG8_SCHED;
            PG8_STAGE(PG8_SB(1, 1), b3 + hstep, voffB);
            PG8_WAIT_V(6); PG8_BAR; PG8_MMA(1, 1, At, B1); PG8_BAR;
            }
        }
        if constexpr (ALIGN_EPI) { if (wr == 0) PG8_BAR; }
        if constexpr (!Epi::AFTER_DRAIN) { E(acc, cur, wr, wc, fr, fq); S.done(cur); }
        if (!has_next) break;
        if (!E.keep(cur)) {
#pragma unroll
        for (int a = 0; a < 2; ++a)
#pragma unroll
            for (int b = 0; b < 2; ++b)
#pragma unroll
                for (int m = 0; m < 4; ++m)
#pragma unroll
                    for (int n = 0; n < 2; ++n) acc[a][b][m][n] = (f32x4){0.f, 0.f, 0.f, 0.f};
        }
        cur = nxt; cA = nA; cB = nB; ++ui;
        if constexpr (ALIGN_EPI) { if (wr == 1) PG8_BAR; }
    }
    PG8_WAIT_V(0);
    if constexpr (!ALIGN_EPI) { if (wr == 0) PG8_BAR; }
    PG8_BAR;
    if constexpr (Epi::AFTER_DRAIN) { E.fused(acc, cur, wr, wc, fr, fq, lds, wid, lane); S.done(cur); }
#undef PG8_SA
#undef PG8_SB
#undef PG8_STAGE
#undef PG8_LDA
#undef PG8_LDB
#undef PG8_MMA
#undef PG8_WAIT_V
#undef PG8_WAIT_L
#undef PG8_BAR
#undef PG8_SCHED
}
template <class Epi, class Sched, bool ALIGN_EPI = false, bool SP2 = false>
__device__ __forceinline__ void gemm_phase_ga(PG8_LAS unsigned char* lds, const Gemm g, const Sched& S, const Epi& E, const PG8_LAS int* rowtab) {
    int tid_ = threadIdx.x; asm volatile("" : "+v"(tid_));
    const int tid = tid_, wid = __builtin_amdgcn_readfirstlane(tid >> 6), lane = tid & 63, wr = wid >> 2, wc = wid & 3, fr = lane & 15, fq = lane >> 4;
    const int K = g.K, nt = K / BK;
    unsigned voffA[2], voffB[2]; int rowA[2];
#pragma unroll
    for (int i = 0; i < 2; ++i) { int R, C; stage_rc(tid * 16 + i * 8192, R, C); const int Rb = Epi::PERM ? ((R & ~31) + perm32(R & 31)) : R;
        voffA[i] = (unsigned)C * 2u; rowA[i] = R; voffB[i] = (unsigned)(Rb * K + C) * 2u; }
    const size_t kstep = (size_t)(BK * 2);
    const size_t hstep = (size_t)HALF * K * 2;
    const size_t tstep = 2 * hstep;
    const unsigned ldsw = (unsigned)wid * 1024u;
    const int aoff = lds_byte(wr * 64 + fr, fq * 8), boff = lds_byte(wc * 32 + fr, fq * 8);
#define PG8_SA(b, h) (((b) * 2 + (h)) * HTB)
#define PG8_SB(b, h) ((4 + (b) * 2 + (h)) * HTB)
#define PG8_STAGE(bufoff, gbase, voff) do { _Pragma("unroll") for (int _i = 0; _i < 2; ++_i) \
        __builtin_amdgcn_global_load_lds((const unsigned*)((const char*)(gbase) + (voff)[_i]), (PG8_LAS unsigned*)(lds + (bufoff) + ldsw + _i * 8192), 16, 0, 0); } while (0)
#define PG8_LDA(dst, b, h) do { _Pragma("unroll") for (int m = 0; m < 4; ++m) _Pragma("unroll") for (int k = 0; k < 2; ++k) dst[m][k] = *(const PG8_LAS bf16x8*)(lds + PG8_SA(b, h) + aoff + m * 2048 + k * 1024); } while (0)
#define PG8_LDB(dst, b, h) do { _Pragma("unroll") for (int n = 0; n < 2; ++n) _Pragma("unroll") for (int k = 0; k < 2; ++k) dst[n][k] = *(const PG8_LAS bf16x8*)(lds + PG8_SB(b, h) + boff + n * 2048 + k * 1024); } while (0)
#define PG8_MMA(ai, bj, At, Bt) do { __builtin_amdgcn_s_setprio(1); _Pragma("unroll") for (int m = 0; m < 4; ++m) _Pragma("unroll") for (int n = 0; n < 2; ++n) _Pragma("unroll") for (int k = 0; k < 2; ++k) \
        acc[ai][bj][m][n] = __builtin_amdgcn_mfma_f32_16x16x32_bf16(Bt[n][k], At[m][k], acc[ai][bj][m][n], 0, 0, 0); __builtin_amdgcn_s_setprio(0); } while (0)
#define PG8_WAIT_V(n) asm volatile("s_waitcnt vmcnt(" #n ")" ::: "memory")
#define PG8_WAIT_L(n) asm volatile("s_waitcnt lgkmcnt(" #n ")" ::: "memory")
#define PG8_BAR __builtin_amdgcn_s_barrier()
#define PG8_SCHED __builtin_amdgcn_sched_barrier(0)
    Unit cur, nxt; int ui = 0;
    if (!S.next(0, cur)) return;
    f32x4 acc[2][2][4][2];
#pragma unroll
    for (int a = 0; a < 2; ++a)
#pragma unroll
        for (int b = 0; b < 2; ++b)
#pragma unroll
            for (int m = 0; m < 4; ++m)
#pragma unroll
                for (int n = 0; n < 2; ++n) acc[a][b][m][n] = (f32x4){0.f, 0.f, 0.f, 0.f};
    bf16x8 At[4][2], B0[2][2], B1[2][2];
    const char* cA = (const char*)g.A; const char* cB = (const char*)g.Bt + (size_t)cur.pn * tstep;
    unsigned vc0[2], vc1[2], vn0[2], vn1[2];
#define PG8_GOFF(dst0, dst1, u_) do { _Pragma("unroll") for (int _i = 0; _i < 2; ++_i) { dst0[_i] = (unsigned)rowtab[(u_) * 256 + rowA[_i]] * (unsigned)(K * 2) + voffA[_i]; dst1[_i] = (unsigned)rowtab[(u_) * 256 + 128 + rowA[_i]] * (unsigned)(K * 2) + voffA[_i]; } } while (0)
    PG8_GOFF(vc0, vc1, 0); vn0[0] = vc0[0]; vn0[1] = vc0[1]; vn1[0] = vc1[0]; vn1[1] = vc1[1];
    S.a_ready(cur);
    if constexpr (SP2) {
        PG8_STAGE(PG8_SB(0, 0), cB, voffB); PG8_STAGE(PG8_SB(0, 1), cB + hstep, voffB); PG8_STAGE(PG8_SA(0, 0), cA, vc0); PG8_STAGE(PG8_SA(0, 1), cA, vc1);
        if (wr == 1) PG8_BAR;
        PG8_WAIT_V(2); PG8_BAR;
        PG8_STAGE(PG8_SB(1, 0), cB + kstep, voffB); PG8_STAGE(PG8_SA(1, 0), cA + kstep, vc0); PG8_STAGE(PG8_SB(1, 1), cB + hstep + kstep, voffB);
        PG8_WAIT_V(6); PG8_BAR;
    } else {
        PG8_STAGE(PG8_SB(0, 0), cB, voffB); PG8_STAGE(PG8_SA(0, 0), cA, voffA); PG8_STAGE(PG8_SB(0, 1), cB + hstep, voffB); PG8_STAGE(PG8_SA(0, 1), cA + hstep, voffA);
        if (wr == 1) PG8_BAR;
        PG8_WAIT_V(4); PG8_BAR;
        PG8_STAGE(PG8_SB(1, 0), cB + kstep, voffB); PG8_STAGE(PG8_SA(1, 0), cA + kstep, voffA); PG8_STAGE(PG8_SB(1, 1), cB + hstep + kstep, voffB);
        PG8_WAIT_V(6); PG8_BAR;
    }
    for (;;) {
        const bool has_next = S.next(ui + 1, nxt);
        const char* nA = cA; const char* nB = has_next ? (const char*)g.Bt + (size_t)nxt.pn * tstep : cB;
        if (has_next) PG8_GOFF(vn0, vn1, ui + 1);
#pragma unroll 1
        for (int t = 0; t < nt; t += 2) {
            const bool last = (t == nt - 2);
            const char* a1 = cA + (size_t)(t + 1) * kstep;
            const char* a2 = last ? nA : cA + (size_t)(t + 2) * kstep; const char* b2 = last ? nB : cB + (size_t)(t + 2) * kstep;
            const char* a3 = a2 + kstep; const char* b3 = b2 + kstep;
            unsigned s0[2], s1[2];
#pragma unroll
            for (int _i = 0; _i < 2; ++_i) { s0[_i] = last ? vn0[_i] : vc0[_i]; s1[_i] = last ? vn1[_i] : vc1[_i]; }
            if (last && has_next) S.a_ready(nxt);
            if constexpr (SP2) {
            PG8_LDB(B0, 0, 0); PG8_LDB(B1, 0, 1); PG8_SCHED; PG8_LDA(At, 0, 0); PG8_STAGE(PG8_SA(1, 1), a1, vc1);
            PG8_WAIT_V(8); PG8_WAIT_L(0); PG8_BAR; PG8_MMA(0, 0, At, B0); PG8_MMA(0, 1, At, B1); PG8_BAR; PG8_SCHED;
            PG8_LDA(At, 0, 1); PG8_STAGE(PG8_SB(0, 0), b2, voffB); PG8_STAGE(PG8_SB(0, 1), b2 + hstep, voffB); PG8_STAGE(PG8_SA(0, 0), a2, s0);
            PG8_WAIT_V(8); PG8_WAIT_L(0); PG8_BAR; PG8_MMA(1, 0, At, B0); PG8_MMA(1, 1, At, B1); PG8_BAR; PG8_SCHED;
            PG8_LDB(B0, 1, 0); PG8_LDB(B1, 1, 1); PG8_SCHED; PG8_LDA(At, 1, 0); PG8_STAGE(PG8_SA(0, 1), a2, s1);
            PG8_WAIT_V(8); PG8_WAIT_L(0); PG8_BAR; PG8_MMA(0, 0, At, B0); PG8_MMA(0, 1, At, B1); PG8_BAR; PG8_SCHED;
            PG8_LDA(At, 1, 1); PG8_STAGE(PG8_SB(1, 0), b3, voffB); PG8_STAGE(PG8_SB(1, 1), b3 + hstep, voffB); PG8_STAGE(PG8_SA(1, 0), a3, s0);
            PG8_WAIT_V(8); PG8_WAIT_L(0); PG8_BAR; PG8_MMA(1, 0, At, B0); PG8_MMA(1, 1, At, B1); PG8_BAR; PG8_SCHED;
            } else {
            PG8_LDB(B0, 0, 0); PG8_SCHED; PG8_LDA(At, 0, 0); PG8_STAGE(PG8_SA(1, 1), a1 + hstep, voffA);
            PG8_WAIT_L(8); PG8_BAR; PG8_WAIT_L(0); PG8_MMA(0, 0, At, B0); PG8_BAR; PG8_SCHED;
            PG8_LDB(B1, 0, 1); PG8_STAGE(PG8_SB(0, 0), b2, voffB);
            PG8_BAR; PG8_WAIT_L(0); PG8_MMA(0, 1, At, B1); PG8_BAR;
            PG8_LDA(At, 0, 1); PG8_STAGE(PG8_SA(0, 0), a2, voffA);
            PG8_BAR; PG8_WAIT_L(0); PG8_MMA(1, 0, At, B0); PG8_BAR; PG8_SCHED;
            PG8_STAGE(PG8_SB(0, 1), b2 + hstep, voffB);
            PG8_WAIT_V(6); PG8_BAR; PG8_MMA(1, 1, At, B1); PG8_BAR;
            PG8_LDB(B0, 1, 0); PG8_SCHED; PG8_LDA(At, 1, 0); PG8_STAGE(PG8_SA(0, 1), a2 + hstep, voffA);
            PG8_WAIT_L(8); PG8_BAR; PG8_WAIT_L(0); PG8_MMA(0, 0, At, B0); PG8_BAR; PG8_SCHED;
            PG8_LDB(B1, 1, 1); PG8_STAGE(PG8_SB(1, 0), b3, voffB);
            PG8_BAR; PG8_WAIT_L(0); PG8_MMA(0, 1, At, B1); PG8_BAR;
            PG8_LDA(At, 1, 1); PG8_STAGE(PG8_SA(1, 0), a3, voffA);
            PG8_BAR; PG8_WAIT_L(0); PG8_MMA(1, 0, At, B0); PG8_BAR; PG8_SCHED;
            PG8_STAGE(PG8_SB(1, 1), b3 + hstep, voffB);
            PG8_WAIT_V(6); PG8_BAR; PG8_MMA(1, 1, At, B1); PG8_BAR;
            }
        }
        if constexpr (ALIGN_EPI) { if (wr == 0) PG8_BAR; }
        if constexpr (!Epi::AFTER_DRAIN) { E(acc, cur, wr, wc, fr, fq); S.done(cur); }
        if (!has_next) break;
        if (!E.keep(cur)) {
#pragma unroll
        for (int a = 0; a < 2; ++a)
#pragma unroll
            for (int b = 0; b < 2; ++b)
#pragma unroll
                for (int m = 0; m < 4; ++m)
#pragma unroll
                    for (int n = 0; n < 2; ++n) acc[a][b][m][n] = (f32x4){0.f, 0.f, 0.f, 0.f};
        }
        cur = nxt; cA = nA; cB = nB; ++ui;
        vc0[0] = vn0[0]; vc0[1] = vn0[1]; vc1[0] = vn1[0]; vc1[1] = vn1[1];
        if constexpr (ALIGN_EPI) { if (wr == 1) PG8_BAR; }
    }
    PG8_WAIT_V(0);
    if constexpr (!ALIGN_EPI) { if (wr == 0) PG8_BAR; }
    PG8_BAR;
    if constexpr (Epi::AFTER_DRAIN) { E.fused(acc, cur, wr, wc, fr, fq, lds, wid, lane); S.done(cur); }
#undef PG8_SA
#undef PG8_SB
#undef PG8_STAGE
#undef PG8_LDA
#undef PG8_LDB
#undef PG8_MMA
#undef PG8_WAIT_V
#undef PG8_WAIT_L
#undef PG8_BAR
#undef PG8_SCHED
#undef PG8_GOFF
}
}

#define XB_TMO      128
#define XB_XCNT(j)  (256  + 64 * (j))
#define XB_XSUB(j)  (1280 + 64 * (j))
#define XB_XGEN(j)  (2304 + 64 * (j))
#define XB_TOP      3328
#define XB_TOPGEN   3392
#define XCD_BAR_WORDS 3456
#define XB_SPIN_CAP (1u << 18)

__device__ __forceinline__ unsigned xb_ld(unsigned* p)              { return __hip_atomic_load(p, __ATOMIC_RELAXED, __HIP_MEMORY_SCOPE_AGENT); }
__device__ __forceinline__ unsigned xb_add(unsigned* p, unsigned v) { return __hip_atomic_fetch_add(p, v, __ATOMIC_RELAXED, __HIP_MEMORY_SCOPE_AGENT); }
__device__ __forceinline__ unsigned xb_xcc_id() { return (unsigned)__builtin_amdgcn_s_getreg((3 << 11) | 20) & 0xFu; }
#define XB_SPIN(cond, bar) do { unsigned _sp = 0; while (cond) { __builtin_amdgcn_s_sleep(1); \
    if ((++_sp & 255u) == 0u) { if (xb_ld(&(bar)[XB_TMO])) break; if (_sp > XB_SPIN_CAP) { atomicAdd(&(bar)[XB_TMO], 1u); break; } } } } while (0)

struct XcdBarrier {
    unsigned* bar; unsigned x;
    volatile LAS unsigned* st;
};

__device__ __forceinline__ XcdBarrier xcd_barrier_post(unsigned* bar, volatile LAS unsigned* st) {
    XcdBarrier b; b.bar = bar; b.x = xb_xcc_id(); b.st = st;
    if (threadIdx.x == 0) (void)xb_add(&bar[XB_XCNT(b.x)], 1u);
    return b;
}
__device__ __forceinline__ void xcd_barrier_complete(unsigned* bar, unsigned x, unsigned& nloc, unsigned& nx) {
    const unsigned G = gridDim.x * gridDim.y * gridDim.z;
    unsigned sum, cnt, mine, sp = 0u;
    for (;;) {
        sum = 0u; cnt = 0u; mine = 0u;
#pragma unroll
        for (unsigned j = 0; j < 16; ++j) { const unsigned c = xb_ld(&bar[XB_XCNT(j)]); sum += c; cnt += (c > 0u) ? 1u : 0u; mine = (j == x) ? c : mine; }
        if (sum == G) break;
        __builtin_amdgcn_s_sleep(1);
        if ((++sp & 255u) == 0u) { if (xb_ld(&bar[XB_TMO])) break; if (sp > XB_SPIN_CAP) { atomicAdd(&bar[XB_TMO], 1u); break; } }
    }
    nloc = mine > 0u ? mine : 1u; nx = cnt > 0u ? cnt : 1u;
}

__device__ __forceinline__ void xcd_barrier(const XcdBarrier& b) {
    asm volatile("s_waitcnt vmcnt(0)" ::: "memory");
    __syncthreads();
    if (threadIdx.x == 0) {
        unsigned* bar = b.bar;
        __builtin_amdgcn_s_waitcnt(0);
        unsigned nloc = b.st[0], nx = b.st[1];
        if (nloc == 0u) { xcd_barrier_complete(bar, b.x, nloc, nx); b.st[0] = nloc; b.st[1] = nx; }
        const unsigned old = xb_add(&bar[XB_XSUB(b.x)], 1u);
        const unsigned gen = old / nloc;
        if (old + 1u == (gen + 1u) * nloc) {
            __builtin_amdgcn_fence(__ATOMIC_RELEASE, "agent");
            asm volatile("s_waitcnt vmcnt(0)" ::: "memory");
            const unsigned og = xb_add(&bar[XB_TOP], 1u);
            const unsigned tg = og / nx;
            if (og + 1u == (tg + 1u) * nx) xb_add(&bar[XB_TOPGEN], 1u);
            else XB_SPIN(xb_ld(&bar[XB_TOPGEN]) == tg, bar);
            __builtin_amdgcn_fence(__ATOMIC_ACQUIRE, "agent");
            xb_add(&bar[XB_XGEN(b.x)], 1u);
            asm volatile("s_waitcnt vmcnt(0)" ::: "memory");
        } else {
            XB_SPIN(xb_ld(&bar[XB_XGEN(b.x)]) == gen, bar);
            __builtin_amdgcn_fence(__ATOMIC_ACQUIRE, "agent");
            asm volatile("s_waitcnt vmcnt(0)" ::: "memory");
        }
    }
    __syncthreads();
}

#define HD __device__ __forceinline__
#define SCHED_FENCE() __builtin_amdgcn_sched_barrier(0)
#define OPAQUE(x) asm volatile("" : "+v"(x))
#ifdef FFT_HOST
struct c32 { float x, y; };
#else
typedef float c32 __attribute__((ext_vector_type(2)));
#endif
HD c32 cmul(c32 a, c32 b) { c32 r; r.x = a.x * b.x - a.y * b.y; r.y = a.x * b.y + a.y * b.x; return r; }
HD c32 cmulc(c32 a, c32 b) { c32 r; r.x = a.x * b.x + a.y * b.y; r.y = a.y * b.x - a.x * b.y; return r; }
HD c32 cadd(c32 a, c32 b) { c32 r; r.x = a.x + b.x; r.y = a.y + b.y; return r; }
HD c32 csub(c32 a, c32 b) { c32 r; r.x = a.x - b.x; r.y = a.y - b.y; return r; }
HD c32 cconj(c32 a) { c32 r; r.x = a.x; r.y = -a.y; return r; }
HD int fpad(int e) { return e + ((e >> 6) << 2); }
#define FFT_L 16384
#define FFT_LDS_ELEMS (FFT_L + (FFT_L >> 6) * 4)
#ifdef FFT_HOST
struct f2p { float x, y; };
static inline f2p operator+(f2p a, f2p b) { return {a.x + b.x, a.y + b.y}; }
static inline f2p operator-(f2p a, f2p b) { return {a.x - b.x, a.y - b.y}; }
static inline f2p operator*(f2p a, f2p b) { return {a.x * b.x, a.y * b.y}; }
static inline f2p operator-(f2p a) { return {-a.x, -a.y}; }
static inline f2p f2splat(float v) { return {v, v}; }
#else
typedef float f2p __attribute__((ext_vector_type(2)));
HD f2p f2splat(float v) { return (f2p){v, v}; }
#endif
struct cxp { f2p x, y; };
HD cxp pmul(cxp a, cxp b) { cxp r; r.x = a.x * b.x - a.y * b.y; r.y = a.x * b.y + a.y * b.x; return r; }
HD cxp pmulc(cxp a, cxp b) { cxp r; r.x = a.x * b.x + a.y * b.y; r.y = a.y * b.x - a.x * b.y; return r; }
HD cxp padd(cxp a, cxp b) { cxp r; r.x = a.x + b.x; r.y = a.y + b.y; return r; }
HD cxp psub(cxp a, cxp b) { cxp r; r.x = a.x - b.x; r.y = a.y - b.y; return r; }
HD cxp pconst(float re, float im) { cxp r; r.x = f2splat(re); r.y = f2splat(im); return r; }
template <bool INV> HD void bfly4(cxp& a0, cxp& a1, cxp& a2, cxp& a3) {
    const cxp b0 = padd(a0, a2), b1 = psub(a0, a2), b2 = padd(a1, a3), b3 = psub(a1, a3);
    cxp ib3;
    if (!INV) { ib3.x = b3.y; ib3.y = -b3.x; } else { ib3.x = -b3.y; ib3.y = b3.x; }
    a0 = padd(b0, b2); a2 = psub(b0, b2); a1 = padd(b1, ib3); a3 = psub(b1, ib3);
}
HD cxp twid2(int j0, int j1, int n) { float s0, c0, s1, c1; sincospif(-2.0f * (float)j0 / (float)n, &s0, &c0); sincospif(-2.0f * (float)j1 / (float)n, &s1, &c1);
    cxp r; r.x.x = c0; r.x.y = c1; r.y.x = s0; r.y.y = s1; return r; }
HD void r16_fwd(cxp (&x)[16], cxp t1) {
    const float C8 = 0.92387953251128674f, S8 = 0.38268343236508977f, R2 = 0.70710678118654752f;
#pragma unroll
    for (int u = 0; u < 4; ++u) {
        bfly4<false>(x[u], x[u + 4], x[u + 8], x[u + 12]);
        const cxp wu = (u == 0) ? pconst(1.f, 0.f) : (u == 1) ? pconst(C8, -S8) : (u == 2) ? pconst(R2, -R2) : pconst(S8, -C8);
        const cxp a1 = (u == 0) ? t1 : pmul(t1, wu), a2 = pmul(a1, a1), a3 = pmul(a2, a1);
        x[u + 4] = pmul(x[u + 4], a1); x[u + 8] = pmul(x[u + 8], a2); x[u + 12] = pmul(x[u + 12], a3);
    }
    const cxp t2 = pmul(t1, t1), b1 = pmul(t2, t2), b2 = pmul(b1, b1), b3 = pmul(b2, b1);
#pragma unroll
    for (int p = 0; p < 4; ++p) {
        bfly4<false>(x[4 * p], x[4 * p + 1], x[4 * p + 2], x[4 * p + 3]);
        x[4 * p + 1] = pmul(x[4 * p + 1], b1); x[4 * p + 2] = pmul(x[4 * p + 2], b2); x[4 * p + 3] = pmul(x[4 * p + 3], b3);
    }
}
HD void r16_inv(cxp (&x)[16], cxp t1) {
    const float C8 = 0.92387953251128674f, S8 = 0.38268343236508977f, R2 = 0.70710678118654752f;
    const cxp t2 = pmul(t1, t1), b1 = pmul(t2, t2), b2 = pmul(b1, b1), b3 = pmul(b2, b1);
#pragma unroll
    for (int p = 0; p < 4; ++p) {
        x[4 * p + 1] = pmulc(x[4 * p + 1], b1); x[4 * p + 2] = pmulc(x[4 * p + 2], b2); x[4 * p + 3] = pmulc(x[4 * p + 3], b3);
        bfly4<true>(x[4 * p], x[4 * p + 1], x[4 * p + 2], x[4 * p + 3]);
    }
#pragma unroll
    for (int u = 0; u < 4; ++u) {
        const cxp wu = (u == 0) ? pconst(1.f, 0.f) : (u == 1) ? pconst(C8, -S8) : (u == 2) ? pconst(R2, -R2) : pconst(S8, -C8);
        const cxp a1 = (u == 0) ? t1 : pmul(t1, wu), a2 = pmul(a1, a1), a3 = pmul(a2, a1);
        x[u + 4] = pmulc(x[u + 4], a1); x[u + 8] = pmulc(x[u + 8], a2); x[u + 12] = pmulc(x[u + 12], a3);
        bfly4<true>(x[u], x[u + 4], x[u + 8], x[u + 12]);
    }
}
template <bool INV, int N, class P, class T, bool ZP = false, bool HO = false> HD void fft_pass16(P d, T tw, int tid) {
    OPAQUE(tid);
    constexpr int s = N >> 4, sp = (s >= 64) ? s + ((s >> 6) << 2) : s;
    const int b0 = tid, b1 = tid + 512;
    const int blk0 = b0 / s, j0 = b0 - blk0 * s, p0 = fpad(blk0 * N + j0), blk1 = b1 / s, j1 = b1 - blk1 * s, p1 = fpad(blk1 * N + j1);
    cxp x[16];
    { c32 ra[16], rb[16];
#pragma unroll
      for (int q = 0; q < 16; ++q) { if (ZP && q >= 8) { ra[q].x = 0.f; ra[q].y = 0.f; rb[q] = ra[q]; } else { ra[q] = d[p0 + q * sp]; rb[q] = d[p1 + q * sp]; } }
      SCHED_FENCE();
#pragma unroll
      for (int q = 0; q < 16; ++q) { x[q].x.x = ra[q].x; x[q].x.y = rb[q].x; x[q].y.x = ra[q].y; x[q].y.y = rb[q].y; } }
    cxp t1; { const c32 ta = tw[j0 * (FFT_L / N)], tb = tw[j1 * (FFT_L / N)]; t1.x.x = ta.x; t1.x.y = tb.x; t1.y.x = ta.y; t1.y.y = tb.y; }
    if (!INV) r16_fwd(x, t1); else r16_inv(x, t1);
#pragma unroll
    for (int q = 0; q < 16; ++q) { if (HO && q >= 8) continue; c32 a, b; a.x = x[q].x.x; a.y = x[q].y.x; b.x = x[q].x.y; b.y = x[q].y.y; d[p0 + q * sp] = a; d[p1 + q * sp] = b; }
}
template <bool INV, class P> HD void fft_pass4(P d, int tid) {
    OPAQUE(tid);
#pragma unroll 1
    for (int b = tid; b < FFT_L / 4; b += 1024) {
        const int ba = fpad(4 * b), bb = fpad(4 * (b + 512));
        cxp a[4];
#pragma unroll
        for (int q = 0; q < 4; ++q) { const c32 u = d[ba + q], v = d[bb + q]; a[q].x.x = u.x; a[q].x.y = v.x; a[q].y.x = u.y; a[q].y.y = v.y; }
        bfly4<INV>(a[0], a[1], a[2], a[3]);
#pragma unroll
        for (int q = 0; q < 4; ++q) { c32 u, v; u.x = a[q].x.x; u.y = a[q].y.x; v.x = a[q].x.y; v.y = a[q].y.y; d[ba + q] = u; d[bb + q] = v; }
    }
}
HD int rev4(int k) {
    unsigned x = (unsigned)k;
    x = ((x & 0x5555u) << 1) | ((x >> 1) & 0x5555u);
    x = ((x & 0x3333u) << 2) | ((x >> 2) & 0x3333u);
    x = ((x & 0x0f0fu) << 4) | ((x >> 4) & 0x0f0fu);
    x = ((x & 0x00ffu) << 8) | ((x >> 8) & 0x00ffu);
    x >>= 2;
    x = ((x & 0x1555u) << 1) | ((x >> 1) & 0x1555u);
    return (int)x;
}
HD void conv_pair(c32 C1, c32 C2, c32 K1, c32 K2, c32 w1, c32& D1, c32& D2) {
    c32 E1, O1;
    E1.x = 0.5f * (C1.x + C2.x); E1.y = 0.5f * (C1.y - C2.y);
    const float dx = 0.5f * (C1.x - C2.x), dy = 0.5f * (C1.y + C2.y);
    O1.x = dy; O1.y = -dx;
    const c32 wO = cmul(w1, O1);
    const c32 X1 = cadd(E1, wO), X2 = cconj(csub(E1, wO));
    const c32 Y1 = cmul(X1, K1), Y2 = cmul(X2, K2);
    c32 Ey, T;
    Ey.x = 0.5f * (Y1.x + Y2.x); Ey.y = 0.5f * (Y1.y - Y2.y);
    T.x = 0.5f * (Y1.x - Y2.x); T.y = 0.5f * (Y1.y + Y2.y);
    const c32 Oy = cmulc(T, w1);
    D1.x = Ey.x - Oy.y; D1.y = Ey.y + Oy.x;
    D2.x = Ey.x - Oy.y; D2.y = -Ey.y - Oy.x;
    D2.x = Ey.x + Oy.y; D2.y = Oy.x - Ey.y;
}
HD void spec_pair(c32 C1, c32 C2, c32 w1, c32& X1, c32& X2) {
    c32 E1, O1;
    E1.x = 0.5f * (C1.x + C2.x); E1.y = 0.5f * (C1.y - C2.y);
    const float dx = 0.5f * (C1.x - C2.x), dy = 0.5f * (C1.y + C2.y);
    O1.x = dy; O1.y = -dx;
    const c32 wO = cmul(w1, O1);
    X1 = cadd(E1, wO); X2 = cconj(csub(E1, wO));
}
struct Args { const float* in[34]; float* out; unsigned char* ws; };
enum { I_X = 0, I_C, I_CTX, I_CCTX, I_ADAW, I_ADAB, I_WIN, I_SINK, I_POOLW, I_POOLS, I_HYCW, I_HYCB, I_HYW1, I_HYB1, I_HYF1, I_HYW2, I_HYB2, I_HYF2, I_HYW3, I_HYBIAS,
       I_SCW, I_WBR, I_WOUT, I_LN1G, I_LN1B, I_LN2G, I_LN2B, I_RGW, I_RGB, I_REW, I_REB, I_EW1, I_EW3, I_EW2 };
struct Frame {
    LAS unsigned char* lds; volatile LAS unsigned* MISC;
    int tid, lane, wave, vcu, G, bid;
    const float* const* in; unsigned char* ws; float* out;
};
#define WSP(T, off) ((T*)(F.ws + (off)))

__device__ __forceinline__ void p0_mods(Frame& F) {
    LAS float* sl = (LAS float*)F.lds; LAS float* sc = sl + 1024; LAS float* red = sc + 1024;
    const float* c = F.in[I_C]; const float* cc = F.in[I_CCTX];
    for (int i = F.tid; i < 1024; i += 512) { const float a = c[i], b = cc[i]; sl[i] = a / (1.f + expf(-a)); sc[i] = b / (1.f + expf(-b)); }
    __syncthreads();
    float* MOD = WSP(float, WS_MOD);
    for (int item = F.bid; item < 256; item += F.G) {
        const int g = F.tid % 24, ks = F.tid / 24;
        const int col = (item * 24 + g) * 4, layer = col / 6144, n = col % 6144;
        if (ks < 16) {
            const float* W = F.in[I_ADAW] + (size_t)layer * 1024 * 6144 + n;
            f32x4 al = {0.f, 0.f, 0.f, 0.f}, ac = {0.f, 0.f, 0.f, 0.f};
#pragma unroll 8
            for (int k = ks * 64; k < ks * 64 + 64; ++k) { const f32x4 w = *(const GAS f32x4*)(W + (size_t)k * 6144); al += w * sl[k]; ac += w * sc[k]; }
            LAS float* r = red + (ks * 24 + g) * 8;
            r[0] = al.x; r[1] = al.y; r[2] = al.z; r[3] = al.w; r[4] = ac.x; r[5] = ac.y; r[6] = ac.z; r[7] = ac.w;
        }
        __syncthreads();
        if (F.tid < 192) {
            const int g2 = F.tid >> 3, e = F.tid & 7; float s = 0.f;
            for (int k2 = 0; k2 < 16; ++k2) s += red[(k2 * 24 + g2) * 8 + e];
            const int col2 = (item * 24 + g2) * 4, layer2 = col2 / 6144, n2 = col2 % 6144 + (e & 3);
            s += F.in[I_ADAB][layer2 * 6144 + n2];
            MOD[(layer2 * 2 + (e >> 2)) * 6144 + n2] = s;
        }
        __syncthreads();
    }
}
__device__ __forceinline__ void p0_tables(Frame& F) {
    const int gt = F.bid * 512 + F.tid, NT = F.G * 512;
    float* rc = WSP(float, WS_ROPE); float* rs = rc + 320 * 16;
    for (int i = gt; i < 320 * 16; i += NT) {
        const int p = i >> 4, j = i & 15; const float pos = (float)(p < 256 ? p : p - 256);
        const float inv = exp2f(-(float)j * (13.287712379549449f / 16.0f)); const float ang = pos * inv;
        rc[i] = cosf(ang); rs[i] = sinf(ang);
    }
    bf16* W3T = WSP(bf16, WS_W3T);
#pragma unroll 4
    for (int i = gt; i < NLAYER * 64 * 2048; i += NT) {
        const int col = i & 2047, k = (i >> 11) & 63, layer = i >> 17;
        W3T[((size_t)layer * 2048 + col) * 128 + k] = (bf16)f2bf(F.in[I_HYW3][((size_t)layer * 64 + k) * 2048 + col]);
    }
    for (int i = gt; i < NLAYER * 2048 * 32; i += NT) {
        const int q = i & 31, row = i >> 5;
        ((unsigned*)W3T)[(size_t)row * 64 + 32 + q] = 0u;
    }
    const int gw = F.bid * NWAVES + F.wave, NGW = F.G * NWAVES;
    bf16* H2B = WSP(bf16, WS_HDN2B); float* H2C = WSP(float, WS_HDN2C);
    for (int it = gw; it < NLAYER * (ML + MC); it += NGW) {
        const int layer = it / (ML + MC), tt = it % (ML + MC); const bool isc = tt >= ML; const int t = isc ? tt - ML : tt, l = isc ? MC : ML;
        const int j = F.lane;
        float feat = 0.f;
        if (j == 0) feat = (float)t / (float)(l - 1);
        else if (j <= 32) { const int b = (j - 1) & 15; const float fr = 1e-4f + (float)b * ((15.0f - 1e-4f) / 15.0f);
            float u = (float)t * fr / (float)l; u -= rintf(u); float s, c; sincospif(2.f * u, &s, &c); feat = (j <= 16) ? c : -s; }
        const float* w1 = F.in[I_HYW1] + (size_t)layer * 33 * 64; const float* w2 = F.in[I_HYW2] + (size_t)layer * 64 * 64;
        float h = F.in[I_HYB1][layer * 64 + j];
#pragma unroll
        for (int i = 0; i < 33; ++i) h += __shfl(feat, i) * w1[i * 64 + j];
        h = __sinf(F.in[I_HYF1][layer * 64 + j] * h);
        float h2 = F.in[I_HYB2][layer * 64 + j];
#pragma unroll 16
        for (int i = 0; i < 64; ++i) h2 += __shfl(h, i) * w2[i * 64 + j];
        h2 = __sinf(F.in[I_HYF2][layer * 64 + j] * h2);
        if (isc) H2C[((size_t)layer * MC + t) * 64 + j] = h2;
        else { bf16* o = H2B + ((size_t)layer * ML + t) * 128; o[j] = (bf16)f2bf(h2); o[64 + j] = 0; }
    }
}

struct CvtJob { const float* W; bf16* WT; int K, N, mode, rs, roff, k0, n0; };
__device__ __forceinline__ void cvt_load(const CvtJob& J, int lane, f32x4 (&v)[16]) {
    const int kr = lane >> 4, nq = (lane & 15) << 2;
#pragma unroll
    for (int i = 0; i < 16; ++i) v[i] = __builtin_nontemporal_load((const GAS f32x4*)(J.W + (size_t)(J.k0 + 4 * i + kr) * J.N + J.n0 + nq));
}
__device__ __forceinline__ void cvt_store(const CvtJob& J, int lane, const f32x4 (&v)[16], LAS float* scr) {
    const int kr = lane >> 4, nq = (lane & 15) << 2;
#pragma unroll
    for (int i = 0; i < 16; ++i) { LAS float* p = scr + nq * 65 + 4 * i + kr; p[0] = v[i].x; p[65] = v[i].y; p[130] = v[i].z; p[195] = v[i].w; }
    LDS_WAIT(); asm volatile("" ::: "memory");
    const int c = lane & 7;
#pragma unroll
    for (int jj = 0; jj < 8; ++jj) {
        const int nl = (lane >> 3) + 8 * jj, n = J.n0 + nl; int dest;
        if (J.mode == 1) { if (n < 640) { const int d = n & 63; dest = (n & ~63) | (d & 32) | ((d & 15) << 1) | ((d >> 4) & 1); } else dest = n; }
        else dest = J.roff + J.rs * n;
        const LAS float* sp = scr + nl * 65 + 8 * c;
        u32x4 o; o.x = pk2(sp[0], sp[1]); o.y = pk2(sp[2], sp[3]); o.z = pk2(sp[4], sp[5]); o.w = pk2(sp[6], sp[7]);
        *(GAS u32x4*)(J.WT + (size_t)dest * J.K + J.k0 + 8 * c) = o;
    }
    LDS_WAIT(); asm volatile("" ::: "memory");
}
__device__ __forceinline__ CvtJob cvt_decode(Frame& F, int layer, int it) {
    constexpr int I_IN = 4 * 66, I_BR = 2 * 8, I_OUT = 4 * 8, I_E13 = 4 * 4, I_E2 = 2 * 8;
    constexpr int N1 = I_IN, N2 = N1 + 3 * I_BR, N3 = N2 + I_OUT, N4 = N3 + 32 * I_E13, N5 = N4 + 32 * I_E13;
    CvtJob J; int r, nbw;
    if (it < N1) { J.W = F.in[I_WIN] + (size_t)layer * 1024 * INCOLS; J.K = 1024; J.N = INCOLS; J.WT = WSP(bf16, WS_WIN); J.mode = 1; J.rs = 1; J.roff = 0; r = it; nbw = 66; }
    else if (it < N2) { const int q = it - N1, b = q / I_BR, nb = b == 0 ? 0 : b + 1; J.W = F.in[I_WBR] + ((size_t)layer * 4 + nb) * 512 * 1024; J.K = 512; J.N = 1024; J.WT = WSP(bf16, WS_WBR); J.mode = 0; J.rs = 1; J.roff = nb * 1024; r = q - b * I_BR; nbw = 8; }
    else if (it < N3) { J.W = F.in[I_WOUT] + (size_t)layer * 1024 * 1024; J.K = 1024; J.N = 1024; J.WT = WSP(bf16, WS_WOUT); J.mode = 0; J.rs = 1; J.roff = 0; r = it - N2; nbw = 8; }
    else if (it < N4) { const int q = it - N3, e = q / I_E13; J.W = F.in[I_EW1] + ((size_t)layer * 32 + e) * 1024 * 512; J.K = 1024; J.N = 512; J.WT = WSP(bf16, WS_W13); J.mode = 0; J.rs = 2; J.roff = e * 1024; r = q - e * I_E13; nbw = 4; }
    else if (it < N5) { const int q = it - N4, e = q / I_E13; J.W = F.in[I_EW3] + ((size_t)layer * 32 + e) * 1024 * 512; J.K = 1024; J.N = 512; J.WT = WSP(bf16, WS_W13); J.mode = 0; J.rs = 2; J.roff = e * 1024 + 1; r = q - e * I_E13; nbw = 4; }
    else { const int q = it - N5, e = q / I_E2; J.W = F.in[I_EW2] + ((size_t)layer * 32 + e) * 512 * 1024; J.K = 512; J.N = 1024; J.WT = WSP(bf16, WS_W2); J.mode = 0; J.rs = 1; J.roff = e * 1024; r = q - e * I_E2; nbw = 8; }
    if (it >= N3) {
        const int sbw = J.N >> 9, kb = r / sbw, sb = r - kb * sbw;
        J.k0 = kb * 64; J.n0 = sb * 512 + F.wave * 64;
    } else {
    const int kb0 = r / nbw, nb0 = r - kb0 * nbw;
    J.k0 = kb0 * 256 + (F.wave & 3) * 64; J.n0 = nb0 * 128 + (F.wave >> 2) * 64;
    }
    return J;
}
__device__ __forceinline__ void p1_convert(Frame& F, int layer) {
    LAS float* scr = (LAS float*)(F.lds + F.wave * 17408);
    const int gw = F.vcu * NWAVES + F.wave, NGW = F.G * NWAVES;
    constexpr int NITEMS = 4 * 66 + 3 * 16 + 32 + 32 * 16 * 2 + 32 * 16;
    {
        int it = F.vcu;
        f32x4 va[16], vb[16];
        if (it < NITEMS) { CvtJob J = cvt_decode(F, layer, it); cvt_load(J, F.lane, va); }
#pragma unroll 1
        for (; it < NITEMS; it += 2 * F.G) {
            const CvtJob J0 = cvt_decode(F, layer, it);
            const bool h1 = (it + F.G) < NITEMS;
            CvtJob J1 = J0; if (h1) { J1 = cvt_decode(F, layer, it + F.G); cvt_load(J1, F.lane, vb); }
            cvt_store(J0, F.lane, va, scr);
            if (h1) { if (it + 2 * F.G < NITEMS) { const CvtJob J2 = cvt_decode(F, layer, it + 2 * F.G); cvt_load(J2, F.lane, va); } cvt_store(J1, F.lane, vb, scr); }
        }
    }
    const float* pw = F.in[I_POOLW] + (size_t)layer * 4 * 128 * 128; const float* ps = F.in[I_POOLS] + (size_t)layer * 512; const float* wb = F.in[I_WBR] + ((size_t)layer * 4 + 1) * 512 * 1024;
    bf16* WBRT = WSP(bf16, WS_WBR);
    for (int it = gw; it < 512 * 4; it += NGW) {
        const int gc = it >> 2, d0 = (it & 3) * 256 + 4 * F.lane, g = gc >> 7;
        f32x4 a = {0.f, 0.f, 0.f, 0.f};
#pragma unroll 32
        for (int e = 0; e < 128; ++e) { const float coef = pw[(size_t)gc * 128 + e] * ps[g * 128 + e]; a += *(const GAS f32x4*)(wb + (size_t)(g * 128 + e) * 1024 + d0) * coef; }
#pragma unroll
        for (int i = 0; i < 4; ++i) WBRT[(size_t)(1024 + d0 + i) * 512 + gc] = (bf16)f2bf(a[i]);
    }
}

__device__ __forceinline__ void row_load(const float* p, int lane, f32x4 (&v)[4]) {
#pragma unroll
    for (int j = 0; j < 4; ++j) v[j] = *(const GAS f32x4*)(p + 4 * lane + 256 * j);
}
__device__ __forceinline__ void row_load_bf16(const bf16* p, int lane, f32x4 (&v)[4]) {
#pragma unroll
    for (int j = 0; j < 4; ++j) { const u32x2 w = *(const GAS u32x2*)(p + 4 * lane + 256 * j); v[j].x = bflo(w.x); v[j].y = bfhi(w.x); v[j].z = bflo(w.y); v[j].w = bfhi(w.y); }
}
__device__ __forceinline__ void row_norm(f32x4 (&v)[4]) {
    float s = 0.f;
#pragma unroll
    for (int j = 0; j < 4; ++j) s += (v[j].x + v[j].y) + (v[j].z + v[j].w);
    const float mean = wave_sum(s) * (1.f / 1024.f); float q = 0.f;
#pragma unroll
    for (int j = 0; j < 4; ++j) { v[j] = v[j] - mean; q += (v[j].x * v[j].x + v[j].y * v[j].y) + (v[j].z * v[j].z + v[j].w * v[j].w); }
    const float rstd = rsqrtf(wave_sum(q) * (1.f / 1024.f) + LN_EPS);
#pragma unroll
    for (int j = 0; j < 4; ++j) v[j] = v[j] * rstd;
}
__device__ __forceinline__ void row_store_bf16(bf16* p, int lane, const f32x4 (&v)[4]) {
#pragma unroll
    for (int j = 0; j < 4; ++j) { u32x2 w; w.x = pk2(v[j].x, v[j].y); w.y = pk2(v[j].z, v[j].w); *(GAS u32x2*)(p + 4 * lane + 256 * j) = w; }
}
__device__ __forceinline__ void p_xn0(Frame& F) {
    const int gw = F.vcu * NWAVES + F.wave, NGW = F.G * NWAVES;
    const float* MOD = WSP(float, WS_MOD); bf16* XN = WSP(bf16, WS_XN);
    for (int r = gw; r < MT; r += NGW) {
        const bool isc = r >= ML; const float* xr = isc ? F.in[I_CTX] + (size_t)(r - ML) * 1024 : F.in[I_X] + (size_t)r * 1024;
        const float* md = MOD + (isc ? 6144 : 0);
        f32x4 v[4]; row_load(xr, F.lane, v); row_norm(v);
#pragma unroll
        for (int j = 0; j < 4; ++j) { const f32x4 sh = *(const GAS f32x4*)(md + 4 * F.lane + 256 * j), sc = *(const GAS f32x4*)(md + 1024 + 4 * F.lane + 256 * j); v[j] = v[j] * (sc + 1.f) + sh; }
        row_store_bf16(XN + (size_t)r * 1024, F.lane, v);
    }
}
__device__ __forceinline__ float block_sum(Frame& F, float v) {
    v = wave_sum(v);
    __syncthreads();
    if (F.lane == 0) ((volatile LAS float*)F.MISC)[32 + F.wave] = v;
    __syncthreads();
    float s = 0.f;
#pragma unroll
    for (int w = 0; w < NWAVES; ++w) s += ((volatile LAS float*)F.MISC)[32 + w];
    return s;
}
#define FTW_LDS(d) ((const LAS c32*)((LAS unsigned char*)(d) + 139264))
template <bool PRUNE = false> __device__ __forceinline__ void fft_forward(LAS c32* d, int tid) {
    const LAS c32* tw = FTW_LDS(d);
    fft_pass16<false, 16384, LAS c32*, const LAS c32*, PRUNE, false>(d, tw, tid); __syncthreads(); fft_pass16<false, 1024>(d, tw, tid); __syncthreads(); fft_pass16<false, 64>(d, tw, tid); __syncthreads(); fft_pass4<false>(d, tid); __syncthreads();
}
template <bool PRUNE = false> __device__ __forceinline__ void fft_inverse(LAS c32* d, int tid) {
    const LAS c32* tw = FTW_LDS(d);
    fft_pass4<true>(d, tid); __syncthreads(); fft_pass16<true, 64>(d, tw, tid); __syncthreads(); fft_pass16<true, 1024>(d, tw, tid); __syncthreads(); fft_pass16<true, 16384, LAS c32*, const LAS c32*, false, PRUNE>(d, tw, tid); __syncthreads();
}
#define PTW_LDS(F) ((volatile LAS c32*)((F).MISC + 64))
__device__ __forceinline__ void ptw_init(Frame& F) {
    { LAS c32* ftw = (LAS c32*)(F.lds + 139264);
#pragma unroll
      for (int q = 0; q < 2; ++q) { const int j = F.tid + 512 * q; float sn, cs; sincospif(-2.0f * (float)j * (1.0f / (float)FFT_L), &sn, &cs); c32 w; w.x = cs; w.y = sn; ftw[j] = w; } }
    if (F.tid < 32) { const int rc = rev4(512 * F.tid); float sn, cs; sincospif(-(float)rc * (1.0f / (float)FFT_L), &sn, &cs); c32 w; w.x = cs; w.y = sn; PTW_LDS(F)[F.tid] = w; }
    __syncthreads();
}
__device__ __forceinline__ float hy_delta(int c) { const float a = -4.605170185988091f / 1.5f, b = -4.605170185988091f / 0.3f; return fabsf(a + (float)c * ((b - a) / 511.0f)); }
__device__ __forceinline__ void filter_unit(Frame& F, int unit) {
    LAS c32* d = (LAS c32*)F.lds;
    const int o = unit >> 9, c = unit & 511;
    const bf16* tf = WSP(bf16, WS_TAPS) + (size_t)((2 * o) * 512 + c) * ML; const bf16* tb = WSP(bf16, WS_TAPS) + (size_t)((2 * o + 1) * 512 + c) * ML;
    const float dl2 = hy_delta(c) * LOG2E * (1.0f / (float)(ML - 1));
    float ss = 0.f;
    int tid = F.tid; OPAQUE(tid);
#pragma unroll 1
    for (int b = 0; b < 2; ++b) {
        unsigned raw[8];
#pragma unroll
        for (int i = 0; i < 8; ++i) raw[i] = *(const GAS unsigned*)(tf + 2 * (tid + 512 * (8 * b + i)));
#pragma unroll
        for (int i = 0; i < 8; ++i) { const int m = tid + 512 * (8 * b + i);
            const float k0 = bflo(raw[i]) * (__builtin_amdgcn_exp2f(-dl2 * (float)(2 * m)) + 0.05f), k1 = bfhi(raw[i]) * (__builtin_amdgcn_exp2f(-dl2 * (float)(2 * m + 1)) + 0.05f);
            ss += k0 * k0 + k1 * k1; c32 v; v.x = k0; v.y = k1; d[fpad(m)] = v; }
    }
#pragma unroll 1
    for (int b = 2; b < 4; ++b) {
        unsigned short ra[8], rb[8];
#pragma unroll
        for (int i = 0; i < 8; ++i) { const int m = tid + 512 * (8 * b + i), j0 = 2 * ML - 2 * m; ra[i] = (j0 < ML) ? tb[j0] : (unsigned short)0; rb[i] = tb[j0 - 1]; }
#pragma unroll
        for (int i = 0; i < 8; ++i) { const int m = tid + 512 * (8 * b + i), j0 = 2 * ML - 2 * m;
            const float k0 = (j0 < ML) ? bf2f(ra[i]) * (__builtin_amdgcn_exp2f(-dl2 * (float)j0) + 0.05f) : 0.f, k1 = bf2f(rb[i]) * (__builtin_amdgcn_exp2f(-dl2 * (float)(j0 - 1)) + 0.05f);
            ss += k0 * k0 + k1 * k1; c32 v; v.x = k0; v.y = k1; d[fpad(m)] = v; }
    }
    unsigned pf0 = 0, pf1 = 0;
    { const int nu = unit + F.G;
      if (nu < 1024) { const int no = nu >> 9, nc = nu & 511;
        const bf16* nb = WSP(bf16, WS_TAPS) + (size_t)((2 * no + (tid >> 8)) * 512 + nc) * ML + (tid & 255) * 64;
        pf0 = *(volatile const GAS unsigned*)nb; pf1 = *(volatile const GAS unsigned*)(nb + 32); } }
    const float tot = block_sum(F, ss);
    const float scale = rsqrtf(tot + LN_EPS) * (1.0f / (float)FFT_L);
    fft_forward(d, tid);
    unsigned* KS = WSP(unsigned, WS_KSPEC) + (size_t)unit * FFT_L;
    OPAQUE(tid);
    const int K0 = rev4(tid); c32 W0; { float sn, cs; sincospif(-(float)K0 * (1.0f / (float)FFT_L), &sn, &cs); W0.x = cs; W0.y = sn; }
    volatile LAS c32* ptw = PTW_LDS(F);
#pragma unroll 4
    for (int i = 0; i < 32; ++i) {
        const int P = tid + 512 * i;
        const int k = rev4(P), P2 = rev4((FFT_L - k) & (FFT_L - 1));
        const c32 w1 = cmul(W0, ptw[i]);
        c32 X1, X2; spec_pair(d[fpad(P)], d[fpad(P2)], w1, X1, X2);
        c32 r; r.x = X1.x * scale; r.y = (k == 0 ? X2.x : X1.y) * scale;
        *(GAS unsigned*)(KS + P) = pk2(r.x, r.y);
    }
    asm volatile("" :: "v"(pf0), "v"(pf1));
    __syncthreads();
}

__device__ __forceinline__ void conv_pairs(Frame& F, LAS c32* d, const unsigned* KS, int tid) {
    OPAQUE(tid);
    const int K0 = rev4(tid); c32 W0; { float sn, cs; sincospif(-(float)K0 * (1.0f / (float)FFT_L), &sn, &cs); W0.x = cs; W0.y = sn; }
    volatile LAS c32* ptw = PTW_LDS(F);
    unsigned r1[8], r2[8];
#pragma unroll
    for (int i = 0; i < 8; ++i) { const int P = tid + 512 * i, Pn = rev4((FFT_L - rev4(P)) & (FFT_L - 1)); r1[i] = 0u; r2[i] = 0u;
        if (P <= Pn) { r1[i] = *(const GAS unsigned*)(KS + P); r2[i] = *(const GAS unsigned*)(KS + Pn); } }
#pragma unroll 1
    for (int b = 0; b < 4; ++b) {
        int P2[8]; c32 K1[8], K2[8];
#pragma unroll
        for (int i = 0; i < 8; ++i) { const int P = tid + 512 * (8 * b + i), k = rev4(P); P2[i] = rev4((FFT_L - k) & (FFT_L - 1));
            K1[i].x = bflo(r1[i]); K1[i].y = bfhi(r1[i]); K2[i].x = bflo(r2[i]); K2[i].y = bfhi(r2[i]); }
        if (b < 3) {
#pragma unroll
            for (int i = 0; i < 8; ++i) { const int P = tid + 512 * (8 * (b + 1) + i), Pn = rev4((FFT_L - rev4(P)) & (FFT_L - 1)); r1[i] = 0u; r2[i] = 0u;
                if (P <= Pn) { r1[i] = *(const GAS unsigned*)(KS + P); r2[i] = *(const GAS unsigned*)(KS + Pn); } }
        }
#pragma unroll
        for (int i = 0; i < 8; ++i) { const int P = tid + 512 * (8 * b + i);
            if (P <= P2[i]) {
                const int k = rev4(P);
                const c32 w1 = cmul(W0, ptw[8 * b + i]);
                c32 k1 = K1[i], k2 = K2[i];
                if (k == 0) { k2.x = k1.y; k2.y = 0.f; k1.y = 0.f; }
                c32 D1, D2; conv_pair(d[fpad(P)], d[fpad(P2[i])], k1, k2, w1, D1, D2);
                d[fpad(P)] = D1; if (P2[i] != P) d[fpad(P2[i])] = D2;
            } }
    }
}
#define WARM(base, stride) (*(volatile const GAS unsigned*)((const char*)(base) + tid * (stride)))
__device__ __forceinline__ void hyena_channel(Frame& F, int layer, int c, unsigned (&outp)[16]) {
    LAS c32* d = (LAS c32*)F.lds;
    const bf16* HT = WSP(bf16, WS_HT);
    const bf16* x1p = HT + (size_t)c * ML; const bf16* x2p = HT + (size_t)(512 + c) * ML; const bf16* vp = HT + (size_t)(1024 + c) * ML;
    const unsigned* KS0 = WSP(unsigned, WS_KSPEC) + (size_t)c * FFT_L; const unsigned* KS1 = WSP(unsigned, WS_KSPEC) + (size_t)(512 + c) * FFT_L;
    const float b0 = F.in[I_HYBIAS][(layer * 2 + 0) * 512 + c], b1 = F.in[I_HYBIAS][(layer * 2 + 1) * 512 + c];
    int tid = F.tid; OPAQUE(tid);
#pragma unroll
    for (int i = 0; i < 16; ++i) { const int m = tid + 512 * i; c32 v; const unsigned w = *(const GAS unsigned*)(vp + 2 * m); v.x = bflo(w); v.y = bfhi(w); d[fpad(m)] = v; }
    const unsigned w0 = WARM(KS0, 128);
    __syncthreads();
    fft_forward<true>(d, tid); asm volatile("" :: "v"(w0)); conv_pairs(F, d, KS0, tid); __syncthreads(); fft_inverse<true>(d, tid);
    c32 z1[16];
    OPAQUE(tid);
#pragma unroll
    for (int i = 0; i < 16; ++i) { const int m = tid + 512 * i; const c32 y = d[fpad(m)];
        const unsigned wv = *(const GAS unsigned*)(vp + 2 * m), wx = *(const GAS unsigned*)(x1p + 2 * m);
        z1[i].x = bflo(wx) * (y.x + b0 * bflo(wv)); z1[i].y = bfhi(wx) * (y.y + b0 * bfhi(wv)); }
    __syncthreads();
    OPAQUE(tid);
#pragma unroll
    for (int i = 0; i < 16; ++i) { const int m = tid + 512 * i; d[fpad(m)] = z1[i]; }
    const unsigned w2 = WARM(KS1, 128);
    __syncthreads();
    fft_forward<true>(d, tid); asm volatile("" :: "v"(w2)); conv_pairs(F, d, KS1, tid); __syncthreads(); fft_inverse<true>(d, tid);
    OPAQUE(tid);
#pragma unroll
    for (int i = 0; i < 16; ++i) { const int m = tid + 512 * i; const c32 y = d[fpad(m)];
        const unsigned wx = *(const GAS unsigned*)(x2p + 2 * m);
        outp[i] = pk2(bflo(wx) * (y.x + b1 * z1[i].x), bfhi(wx) * (y.y + b1 * z1[i].y)); }
    __syncthreads();
}
__device__ __forceinline__ void hyena_unit(Frame& F, int layer, int u) {
    unsigned o0[16], o1[16];
    hyena_channel(F, layer, 2 * u, o0);
    hyena_channel(F, layer, 2 * u + 1, o1);
    bf16* dst = WSP(bf16, WS_ABR) + (size_t)2 * MT * 512 + 2 * u;
    int tid = F.tid; OPAQUE(tid);
#pragma unroll
    for (int i = 0; i < 16; ++i) { const int m = tid + 512 * i;
        *(GAS unsigned*)(dst + (size_t)(2 * m) * 512) = (o0[i] & 0xffffu) | (o1[i] << 16);
        *(GAS unsigned*)(dst + (size_t)(2 * m + 1) * 512) = (o0[i] >> 16) | (o1[i] & 0xffff0000u); }
}
__device__ __forceinline__ void hyena_ctx_unit(Frame& F, int layer, int unit) {
    LAS float* S = (LAS float*)F.lds;
    const int ch = F.tid >> 8, t = F.tid & 255, c = unit * 2 + ch;
    LAS float* w3s = S + ch * 256;
    LAS float* tap = S + 512 + ch * 1024;
    LAS float* zz = S + 2560 + ch * 256;
    LAS float* red = S + 3072;
    const float* w3 = F.in[I_HYW3] + (size_t)layer * 64 * 2048;
    { const int q = t >> 6, j = t & 63; w3s[q * 64 + j] = w3[(size_t)j * 2048 + q * 512 + c]; }
    __syncthreads();
    const float* h2 = WSP(float, WS_HDN2C) + ((size_t)layer * MC + t) * 64;
    float a[4] = {0.f, 0.f, 0.f, 0.f};
#pragma unroll 4
    for (int j4 = 0; j4 < 16; ++j4) { const f32x4 h = *(const GAS f32x4*)(h2 + 4 * j4);
#pragma unroll
        for (int q = 0; q < 4; ++q) a[q] += h.x * w3s[q * 64 + 4 * j4] + h.y * w3s[q * 64 + 4 * j4 + 1] + h.z * w3s[q * 64 + 4 * j4 + 2] + h.w * w3s[q * 64 + 4 * j4 + 3]; }
    const float win = __expf(-((float)t / 255.0f) * hy_delta(c)) + 0.05f;
    float ssq[2];
#pragma unroll
    for (int o = 0; o < 2; ++o) { const float f = a[2 * o] * win, b = a[2 * o + 1] * win; tap[(2 * o) * 256 + t] = f; tap[(2 * o + 1) * 256 + t] = b; ssq[o] = f * f + (t > 0 ? b * b : 0.f); }
    const bf16* HTC = WSP(bf16, WS_HTC);
    const float x1 = bf2f(HTC[(size_t)c * MC + t]), x2 = bf2f(HTC[(size_t)(512 + c) * MC + t]), v = bf2f(HTC[(size_t)(1024 + c) * MC + t]);
    zz[t] = v;
    const float s0 = wave_sum(ssq[0]), s1 = wave_sum(ssq[1]);
    if (F.lane == 0) { red[(ch * 2 + 0) * 4 + (F.wave & 3)] = s0; red[(ch * 2 + 1) * 4 + (F.wave & 3)] = s1; }
    __syncthreads();
    const float sc0 = rsqrtf(red[(ch * 2) * 4] + red[(ch * 2) * 4 + 1] + red[(ch * 2) * 4 + 2] + red[(ch * 2) * 4 + 3] + LN_EPS);
    const float sc1 = rsqrtf(red[(ch * 2 + 1) * 4] + red[(ch * 2 + 1) * 4 + 1] + red[(ch * 2 + 1) * 4 + 2] + red[(ch * 2 + 1) * 4 + 3] + LN_EPS);
    float y = 0.f;
#pragma unroll 16
    for (int s = 0; s < 256; ++s) { const int dlt = t - s; const float kk = tap[dlt >= 0 ? dlt : 256 - dlt]; y += kk * zz[s]; }
    const float z1 = x1 * (sc0 * y + F.in[I_HYBIAS][(layer * 2 + 0) * 512 + c] * v);
    __syncthreads();
    zz[t] = z1;
    __syncthreads();
    y = 0.f;
#pragma unroll 16
    for (int s = 0; s < 256; ++s) { const int dlt = t - s; const float kk = tap[dlt >= 0 ? 512 + dlt : 768 - dlt]; y += kk * zz[s]; }
    const float outv = x2 * (sc1 * y + F.in[I_HYBIAS][(layer * 2 + 1) * 512 + c] * z1);
    WSP(bf16, WS_ABR)[((size_t)2 * MT + ML + t) * 512 + c] = (bf16)f2bf(outv);
    __syncthreads();
}
template <int W> __device__ __forceinline__ void pool_strip(const bf16* U, bf16* O, int ts, int slen, int p) {
    constexpr int left = W / 2, right = W / 2 - 1, NR = 32 + W - 1;
    unsigned raw[NR];
#pragma unroll
    for (int j = 0; j < NR; ++j) { const int t = ts - left + j; raw[j] = (t >= 0 && t < slen) ? *(const GAS unsigned*)(U + (size_t)t * 512 + 2 * p) : 0u; }
    float S0 = 0.f, S1 = 0.f;
#pragma unroll
    for (int j = 0; j < W; ++j) { S0 += bflo(raw[j]); S1 += bfhi(raw[j]); }
#pragma unroll
    for (int i = 0; i < 32; ++i) {
        const int t = ts + i, lo = max(t - left, 0), hi = min(t + right + 1, slen);
        const float inv = __builtin_amdgcn_rcpf((float)(hi - lo));
        *(GAS unsigned*)(O + (size_t)t * 512 + 2 * p) = pk2(S0 * inv - bflo(raw[i + left]), S1 * inv - bfhi(raw[i + left]));
        if (i < 31) { S0 += bflo(raw[i + W]) - bflo(raw[i]); S1 += bfhi(raw[i + W]) - bfhi(raw[i]); }
    }
}
__device__ __forceinline__ void token_block_item(Frame& F, int layer, int seq0, int slen, int t0, bf16* hT, int hT_ld) {
    const int p = F.tid & 255, ts = t0 + 32 * (F.tid >> 8);
    {
        const bf16* U = WSP(bf16, WS_POOL) + (size_t)seq0 * 512; bf16* O = WSP(bf16, WS_ABR) + ((size_t)1 * MT + seq0) * 512;
        const int g = __builtin_amdgcn_readfirstlane(p >> 6);
        if (g == 0) pool_strip<2>(U, O, ts, slen, p); else if (g == 1) pool_strip<4>(U, O, ts, slen, p); else if (g == 2) pool_strip<8>(U, O, ts, slen, p); else pool_strip<16>(U, O, ts, slen, p);
    }
    {
        const bf16* U = WSP(bf16, WS_SC) + (size_t)seq0 * 1536 + 2 * p; bf16* O = WSP(bf16, WS_ABR) + ((size_t)3 * MT + seq0) * 512 + 2 * p;
        const float* cw = F.in[I_SCW] + (size_t)layer * 3 * 512 + 2 * p;
        const f32x2 w0 = *(const GAS f32x2*)cw, w1 = *(const GAS f32x2*)(cw + 512), w2 = *(const GAS f32x2*)(cw + 1024);
        unsigned rc[34], rx[34], rb[32];
#pragma unroll
        for (int j = 0; j < 34; ++j) { const int t = ts - 1 + j; const bool ok = (t >= 0 && t < slen);
            rc[j] = ok ? *(const GAS unsigned*)(U + (size_t)t * 1536 + 512) : 0u; rx[j] = ok ? *(const GAS unsigned*)(U + (size_t)t * 1536 + 1024) : 0u; }
#pragma unroll
        for (int i = 0; i < 32; ++i) rb[i] = *(const GAS unsigned*)(U + (size_t)(ts + i) * 1536);
        float pa0 = bflo(rc[0]) * bflo(rx[0]), pa1 = bfhi(rc[0]) * bfhi(rx[0]), pb0 = bflo(rc[1]) * bflo(rx[1]), pb1 = bfhi(rc[1]) * bfhi(rx[1]);
#pragma unroll
        for (int i = 0; i < 32; ++i) {
            const float pc0 = bflo(rc[i + 2]) * bflo(rx[i + 2]), pc1 = bfhi(rc[i + 2]) * bfhi(rx[i + 2]);
            *(GAS unsigned*)(O + (size_t)(ts + i) * 512) = pk2(bflo(rb[i]) * (w0.x * pa0 + w1.x * pb0 + w2.x * pc0), bfhi(rb[i]) * (w0.y * pa1 + w1.y * pb1 + w2.y * pc1));
            pa0 = pb0; pa1 = pb1; pb0 = pc0; pb1 = pc1;
        }
    }
#pragma unroll 1
    for (int q = 0; q < 3; ++q) {
        const int task = F.tid + 512 * q, pr = task % 768, tsh = t0 + 32 * (task / 768);
        const bf16* U = WSP(bf16, WS_HY) + (size_t)seq0 * 1536 + 2 * pr;
        const float* cw = F.in[I_HYCW] + (size_t)layer * 3 * 1536 + 2 * pr;
        const f32x2 w0 = *(const GAS f32x2*)cw, w1 = *(const GAS f32x2*)(cw + 1536), w2 = *(const GAS f32x2*)(cw + 3072), bb = *(const GAS f32x2*)(F.in[I_HYCB] + layer * 1536 + 2 * pr);
        unsigned ru[34];
#pragma unroll
        for (int j = 0; j < 34; ++j) { const int t = tsh - 1 + j; ru[j] = (t >= 0 && t < slen) ? *(const GAS unsigned*)(U + (size_t)t * 1536) : 0u; }
#pragma unroll
        for (int g8 = 0; g8 < 4; ++g8) {
            float r0[8], r1[8];
#pragma unroll
            for (int i = 0; i < 8; ++i) { const int j = 8 * g8 + i;
                r0[i] = w0.x * bflo(ru[j]) + w1.x * bflo(ru[j + 1]) + w2.x * bflo(ru[j + 2]) + bb.x; r1[i] = w0.y * bfhi(ru[j]) + w1.y * bfhi(ru[j + 1]) + w2.y * bfhi(ru[j + 2]) + bb.y; }
            u32x4 o0, o1; o0.x = pk2(r0[0], r0[1]); o0.y = pk2(r0[2], r0[3]); o0.z = pk2(r0[4], r0[5]); o0.w = pk2(r0[6], r0[7]);
            o1.x = pk2(r1[0], r1[1]); o1.y = pk2(r1[2], r1[3]); o1.z = pk2(r1[4], r1[5]); o1.w = pk2(r1[6], r1[7]);
            *(GAS u32x4*)(hT + (size_t)(2 * pr) * hT_ld + tsh + 8 * g8) = o0; *(GAS u32x4*)(hT + (size_t)(2 * pr + 1) * hT_ld + tsh + 8 * g8) = o1;
        }
    }
}

__device__ __forceinline__ void attn_unit(Frame& F, int layer, int hk, int qrow0, bool latent, int qb) {
    constexpr int KS = 72, VS = 324;
    LAS bf16* Kt = (LAS bf16*)F.lds;
    LAS bf16* Vt = (LAS bf16*)(F.lds + 46080);
    const bf16* Qb = WSP(bf16, WS_Q); const bf16* Kb = WSP(bf16, WS_K); const bf16* Vb = WSP(bf16, WS_V);
    const int lane = F.lane, r = lane & 31, h = lane >> 5, w = F.wave;
    const int head = hk * 4 + (w >> 1), qt0 = qrow0 + (w & 1) * 64;
    LAS bf16x8* Qs = (LAS bf16x8*)(F.lds + 87552) + w * 512;
#pragma unroll
    for (int qq = 0; qq < 2; ++qq)
#pragma unroll
        for (int s = 0; s < 4; ++s) Qs[(qq * 4 + s) * 64 + lane] = *(const GAS bf16x8*)(Qb + (size_t)(qt0 + 32 * qq + r) * 512 + head * 64 + 16 * s + 8 * h);
    const float sink2 = F.in[I_SINK][layer * 8 + head] * LOG2E;
    float mrun[2] = {sink2, sink2}, lsum[2] = {h == 0 ? 1.f : 0.f, h == 0 ? 1.f : 0.f};
    f32x16 O[2][2];
#pragma unroll
    for (int a = 0; a < 2; ++a)
#pragma unroll
        for (int b = 0; b < 2; ++b)
#pragma unroll
            for (int i = 0; i < 16; ++i) O[a][b][i] = 0.f;
    const int nchunk = latent ? 2 : 1;
    const int skey = F.tid >> 3, sch = F.tid & 7;
    auto tile_row0 = [&](int it, bool& valid, bool& masked) -> int {
        if (it < 4) { valid = true; masked = false; return ML + 64 * it; }
        if (!latent) { valid = false; masked = false; return 0; }
        const int j = it - 4, kb = qb - 1 + (j >> 1); valid = (kb >= 0 && kb < ML / 128); masked = (kb != qb); return kb * 128 + (j & 1) * 64;
    };
#pragma unroll 1
    for (int ch = 0; ch < nchunk; ++ch) {
        __syncthreads();
#pragma unroll 1
        for (int jb = 0; jb < 5; jb += 3) {
            u32x4 kreg[3], vreg[3];
#pragma unroll
            for (int j = 0; j < 3; ++j) { bool v0 = false, m0; int r0 = 0; if (jb + j < 5) r0 = tile_row0(5 * ch + jb + j, v0, m0); kreg[j] = (u32x4){0u, 0u, 0u, 0u}; vreg[j] = kreg[j];
                if (v0) { kreg[j] = *(const GAS u32x4*)(Kb + (size_t)(r0 + skey) * 128 + hk * 64 + 8 * sch); vreg[j] = *(const GAS u32x4*)(Vb + (size_t)(r0 + skey) * 128 + hk * 64 + 8 * sch); } }
#pragma unroll
            for (int j = 0; j < 3; ++j) if (jb + j < 5) {
                *(LAS u32x4*)(Kt + (64 * (jb + j) + skey) * KS + 8 * sch) = kreg[j];
#pragma unroll
                for (int i = 0; i < 4; ++i) { Vt[(8 * sch + 2 * i) * VS + 64 * (jb + j) + skey] = (bf16)(vreg[j][i] & 0xffffu); Vt[(8 * sch + 2 * i + 1) * VS + 64 * (jb + j) + skey] = (bf16)(vreg[j][i] >> 16); } }
        }
        __syncthreads();
#pragma unroll 1
        for (int jt = 0; jt < 5; ++jt) {
        bool valid, masked; const int krow0 = tile_row0(5 * ch + jt, valid, masked);
        if (!valid) continue;
        const LAS bf16* Ktj = Kt + 64 * jt * KS; const LAS bf16* Vtj = Vt + 64 * jt;
        bf16x8 pfr[2][2][2];
#pragma unroll
        for (int qq = 0; qq < 2; ++qq) {
            f32x16 S[2];
#pragma unroll
            for (int kb2 = 0; kb2 < 2; ++kb2) {
                f32x16 acc;
#pragma unroll
                for (int i = 0; i < 16; ++i) acc[i] = 0.f;
#pragma unroll
                for (int s = 0; s < 4; ++s) { const bf16x8 kf = *(const LAS bf16x8*)(Ktj + (32 * kb2 + r) * KS + 16 * s + 8 * h); acc = __builtin_amdgcn_mfma_f32_32x32x16_bf16(kf, Qs[(qq * 4 + s) * 64 + lane], acc, 0, 0, 0); }
                S[kb2] = acc;
            }
            if (masked) {
                const int qi = qt0 + 32 * qq + r;
#pragma unroll
                for (int kb2 = 0; kb2 < 2; ++kb2)
#pragma unroll
                    for (int i = 0; i < 16; ++i) { const int kj = krow0 + 32 * kb2 + (i & 3) + 8 * (i >> 2) + 4 * h; const int df = qi - kj; if (df > 128 || df < -128) S[kb2][i] = -1e30f; }
            }
            float tm = S[0][0];
#pragma unroll
            for (int i = 1; i < 16; ++i) tm = fmaxf(tm, S[0][i]);
#pragma unroll
            for (int i = 0; i < 16; ++i) tm = fmaxf(tm, S[1][i]);
            tm = fmaxf(tm, __shfl_xor(tm, 32));
            const float mn = fmaxf(mrun[qq], tm), alpha = __builtin_amdgcn_exp2f(mrun[qq] - mn); mrun[qq] = mn;
            float ps = 0.f;
#pragma unroll
            for (int kb2 = 0; kb2 < 2; ++kb2)
#pragma unroll
                for (int i = 0; i < 16; ++i) { const float p = __builtin_amdgcn_exp2f(S[kb2][i] - mn); S[kb2][i] = p; ps += p; }
            lsum[qq] = lsum[qq] * alpha + ps;
#pragma unroll
            for (int db = 0; db < 2; ++db)
#pragma unroll
                for (int i = 0; i < 16; ++i) O[db][qq][i] *= alpha;
#pragma unroll
            for (int kb2 = 0; kb2 < 2; ++kb2)
#pragma unroll
                for (int s2 = 0; s2 < 2; ++s2) { u32x4 p;
#pragma unroll
                    for (int i = 0; i < 4; ++i) p[i] = pk2(S[kb2][8 * s2 + 2 * i], S[kb2][8 * s2 + 2 * i + 1]);
                    pfr[qq][kb2][s2] = __builtin_bit_cast(bf16x8, p); }
        }
#pragma unroll
        for (int kb2 = 0; kb2 < 2; ++kb2)
#pragma unroll
            for (int s2 = 0; s2 < 2; ++s2)
#pragma unroll
                for (int db = 0; db < 2; ++db) {
                    const LAS bf16* vp = Vtj + (32 * db + r) * VS + 32 * kb2 + 16 * s2 + 4 * h;
                    const s16x4 lo = *(const LAS s16x4*)vp, hi = *(const LAS s16x4*)(vp + 8);
                    const bf16x8 vf = __builtin_shufflevector(lo, hi, 0, 1, 2, 3, 4, 5, 6, 7);
#pragma unroll
                    for (int qq = 0; qq < 2; ++qq) O[db][qq] = __builtin_amdgcn_mfma_f32_32x32x16_bf16(vf, pfr[qq][kb2][s2], O[db][qq], 0, 0, 0);
                }
        }
    }
    bf16* Ob = WSP(bf16, WS_ABR);
#pragma unroll
    for (int qq = 0; qq < 2; ++qq) {
        const float l = lsum[qq] + __shfl_xor(lsum[qq], 32), inv = 1.f / l;
        bf16* orow = Ob + (size_t)(qt0 + 32 * qq + r) * 512 + head * 64;
#pragma unroll
        for (int db = 0; db < 2; ++db)
#pragma unroll
            for (int g = 0; g < 4; ++g) { u32x2 wv; wv.x = pk2(O[db][qq][4 * g] * inv, O[db][qq][4 * g + 1] * inv); wv.y = pk2(O[db][qq][4 * g + 2] * inv, O[db][qq][4 * g + 3] * inv);
                *(GAS u32x2*)(orow + 32 * db + 8 * g + 4 * h) = wv; }
    }
    __syncthreads();
}
struct TokRec { unsigned e01; unsigned lpos0, lpos1; float w0, w1; unsigned pad0, pad1, pad2; };
__device__ __forceinline__ void p9_ln1_router(Frame& F, int layer) {
    LAS float* RW = (LAS float*)F.lds; constexpr int RWS = 1028;
    volatile LAS unsigned* cnt = F.MISC + 64;
    volatile LAS float* lg = (volatile LAS float*)(F.MISC + 128) + F.wave * 40;
    { const float* rg = F.in[I_RGW] + (size_t)layer * 1024 * 4; const float* re = F.in[I_REW] + (size_t)layer * 1024 * 32;
      f32x4 wv[16];
#pragma unroll
      for (int i = 0; i < 16; ++i) wv[i] = *(const GAS f32x4*)(re + 4 * (F.tid + 512 * i));
#pragma unroll
      for (int i = 0; i < 16; ++i) { const int idx = F.tid + 512 * i, k = idx >> 3, o = 4 + 4 * (idx & 7);
          RW[(o + 0) * RWS + k] = wv[i].x; RW[(o + 1) * RWS + k] = wv[i].y; RW[(o + 2) * RWS + k] = wv[i].z; RW[(o + 3) * RWS + k] = wv[i].w; }
#pragma unroll
      for (int i = 0; i < 2; ++i) { const int k = F.tid + 512 * i; const f32x4 g = *(const GAS f32x4*)(rg + 4 * k); RW[0 * RWS + k] = g.x; RW[1 * RWS + k] = g.y; RW[2 * RWS + k] = g.z; RW[3 * RWS + k] = g.w; }
      if (F.tid < 32) cnt[F.tid] = 0u;
      if (F.tid < 36) ((volatile LAS float*)(F.MISC + 448))[F.tid] = (F.tid < 4) ? F.in[I_RGB][layer * 4 + F.tid] : F.in[I_REB][layer * 32 + F.tid - 4]; }
    __syncthreads();
    const int RPW = (MT + F.G - 1) / F.G, r_lo = F.bid * RPW, r_hi = min(r_lo + RPW, MT);
    const float* MOD = WSP(float, WS_MOD) + (size_t)layer * 2 * 6144;
    const bf16* T1 = WSP(bf16, WS_T1); bf16* X = WSP(bf16, WS_X); bf16* HN = WSP(bf16, WS_HN); TokRec* TR = WSP(TokRec, WS_TOKREC);
    const float* g1 = F.in[I_LN1G] + layer * 1024; const float* b1 = F.in[I_LN1B] + layer * 1024;
    const int lane = F.lane;
    volatile LAS float* lg2 = (volatile LAS float*)(F.lds + 148480) + F.wave * 80;
    volatile LAS float* rbias = (volatile LAS float*)(F.MISC + 448);
    f32x4 gg[4], bb[4], vn[2][4];
#pragma unroll
    for (int j = 0; j < 4; ++j) { gg[j] = *(const GAS f32x4*)(g1 + 4 * lane + 256 * j); bb[j] = *(const GAS f32x4*)(b1 + 4 * lane + 256 * j); }
    const int rfirst = r_lo + F.wave;
#pragma unroll
    for (int q = 0; q < 2; ++q) { const int rr = rfirst + q * NWAVES; row_load_bf16(T1 + (size_t)(rr < r_hi ? rr : r_lo) * 1024, lane, vn[q]); }
#pragma unroll 1
    for (int r = rfirst; r < r_hi; r += 2 * NWAVES) {
        const bool ok1 = r + NWAVES < r_hi;
        const int rq[2] = {r, ok1 ? r + NWAVES : r};
        f32x4 v[2][4];
#pragma unroll
        for (int q = 0; q < 2; ++q)
#pragma unroll
            for (int j = 0; j < 4; ++j) v[q][j] = vn[q][j];
#pragma unroll
        for (int q = 0; q < 2; ++q) { const int rr = r + (2 + q) * NWAVES; if (rr < r_hi) row_load_bf16(T1 + (size_t)rr * 1024, lane, vn[q]); }
#pragma unroll
        for (int q = 0; q < 2; ++q) { row_norm(v[q]);
#pragma unroll
            for (int j = 0; j < 4; ++j) v[q][j] = v[q][j] * gg[j] + bb[j]; }
        row_store_bf16(X + (size_t)rq[0] * 1024, lane, v[0]);
        if (ok1) row_store_bf16(X + (size_t)rq[1] * 1024, lane, v[1]);
#pragma unroll
        for (int q = 0; q < 2; ++q) { const float* md = MOD + (rq[q] >= ML ? 6144 : 0); row_norm(v[q]);
#pragma unroll
            for (int j = 0; j < 4; ++j) v[q][j] = v[q][j] * (*(const GAS f32x4*)(md + 4096 + 4 * lane + 256 * j) + 1.f) + *(const GAS f32x4*)(md + 3072 + 4 * lane + 256 * j); }
        row_store_bf16(HN + (size_t)rq[0] * 1024, lane, v[0]);
        if (ok1) row_store_bf16(HN + (size_t)rq[1] * 1024, lane, v[1]);
        float a[2][36];
#pragma unroll
        for (int ob = 0; ob < 36; ob += 2) {
            f32x4 wv[2][4];
#pragma unroll
            for (int o = 0; o < 2; ++o)
#pragma unroll
                for (int j = 0; j < 4; ++j) wv[o][j] = *(const LAS f32x4*)(RW + (ob + o) * RWS + 4 * lane + 256 * j);
            __builtin_amdgcn_sched_barrier(0);
#pragma unroll
            for (int q = 0; q < 2; ++q)
#pragma unroll
                for (int o = 0; o < 2; ++o) { f32x2 s2 = {0.f, 0.f};
#pragma unroll
                    for (int j = 0; j < 4; ++j) { s2 += (f32x2){v[q][j].x, v[q][j].y} * (f32x2){wv[o][j].x, wv[o][j].y}; s2 += (f32x2){v[q][j].z, v[q][j].w} * (f32x2){wv[o][j].z, wv[o][j].w}; }
                    a[q][ob + o] = s2.x + s2.y; }
            __builtin_amdgcn_sched_barrier(0);
        }
#define BFLY_STAGE(NH, XM) { const bool hi = (lane & XM) != 0; _Pragma("unroll") for (int i = 0; i < NH; ++i) _Pragma("unroll") for (int q = 0; q < 2; ++q) { \
            const float snd = hi ? a[q][i] : a[q][NH + i]; const float rc = __shfl_xor(snd, XM); a[q][i] = (hi ? a[q][NH + i] : a[q][i]) + rc; } }
        BFLY_STAGE(18, 32) BFLY_STAGE(9, 16) a[0][9] = 0.f; a[1][9] = 0.f; BFLY_STAGE(5, 8) a[0][5] = 0.f; a[1][5] = 0.f; BFLY_STAGE(3, 4) a[0][3] = 0.f; a[1][3] = 0.f; BFLY_STAGE(2, 2) BFLY_STAGE(1, 1)
#undef BFLY_STAGE
        { const int i1 = lane & 1, i2 = ((lane >> 1) & 1) * 2 + i1, i3 = ((lane >> 2) & 1) * 3 + i2, i4 = ((lane >> 3) & 1) * 5 + i3, i5 = ((lane >> 4) & 1) * 9 + i4, i6 = ((lane >> 5) & 1) * 18 + i5;
          if (i2 < 3 && i3 < 5 && i4 < 9) { lg2[i6] = a[0][0]; lg2[40 + i6] = a[1][0]; } }
        LDS_WAIT(); asm volatile("" ::: "memory");
#pragma unroll
        for (int q = 0; q < 2; ++q) {
            volatile LAS float* lg = lg2 + 40 * q;
            float l4[4]; int gs = 0;
#pragma unroll
            for (int i = 0; i < 4; ++i) l4[i] = lg[i] + rbias[i];
#pragma unroll
            for (int i = 1; i < 4; ++i) if (l4[i] > l4[gs]) gs = i;
            float den = 0.f;
#pragma unroll
            for (int i = 0; i < 4; ++i) den += __expf(l4[i] - l4[gs]);
            const float gate = 1.f / den;
            float le[8];
#pragma unroll
            for (int i = 0; i < 8; ++i) le[i] = lg[4 + gs * 8 + i] + rbias[4 + gs * 8 + i];
            int i0 = 0;
#pragma unroll
            for (int i = 1; i < 8; ++i) if (le[i] > le[i0]) i0 = i;
            int i1 = (i0 == 0) ? 1 : 0;
#pragma unroll
            for (int i = 0; i < 8; ++i) if (i != i0 && le[i] > le[i1]) i1 = i;
            const float ex = __expf(le[i1] - le[i0]), w0 = gate / (1.f + ex), w1 = gate * ex / (1.f + ex);
            const unsigned e0 = gs * 8 + i0, e1 = gs * 8 + i1;
            if (lane == 0 && (q == 0 || ok1)) {
                const unsigned p0 = __hip_atomic_fetch_add((LAS unsigned*)(cnt + e0), 1u, __ATOMIC_RELAXED, __HIP_MEMORY_SCOPE_WORKGROUP);
                const unsigned p1 = __hip_atomic_fetch_add((LAS unsigned*)(cnt + e1), 1u, __ATOMIC_RELAXED, __HIP_MEMORY_SCOPE_WORKGROUP);
                TokRec t; t.e01 = e0 | (e1 << 8); t.lpos0 = p0; t.lpos1 = p1; t.w0 = w0; t.w1 = w1; t.pad0 = 0; t.pad1 = 0; t.pad2 = 0;
                TR[rq[q]] = t;
            }
        }
    }
    __syncthreads();
    if (F.tid < 32) WSP(unsigned, WS_WGCNT)[F.bid * 32 + F.tid] = cnt[F.tid];
}

__device__ __forceinline__ void p10_slots_gather(Frame& F) {
    volatile LAS unsigned* part = (volatile LAS unsigned*)F.lds;
    const unsigned* WGC = WSP(unsigned, WS_WGCNT);
    if (F.tid < 256) { const int e = F.tid & 31, pt = F.tid >> 5; unsigned tot = 0, mine = 0;
        const int wpp = F.G / 8;
#pragma unroll 32
        for (int w2 = 0; w2 < wpp; ++w2) { const int w = pt * wpp + w2; const unsigned v = __builtin_nontemporal_load(WGC + w * 32 + e); tot += v; if (w < F.bid) mine += v; }
        part[pt * 32 + e] = tot; part[256 + pt * 32 + e] = mine; }
    __syncthreads();
    if (F.tid < 32) { unsigned tot = 0, mine = 0; for (int p = 0; p < 8; ++p) { tot += part[p * 32 + F.tid]; mine += part[256 + p * 32 + F.tid]; } part[512 + F.tid] = tot; part[544 + F.tid] = mine; }
    __syncthreads();
    if (F.tid == 0) { unsigned pst = 0; int* PE = WSP(int, WS_PANEL);
        for (int e = 0; e < 32; ++e) { const unsigned np = (part[512 + e] + 255u) >> 8; part[576 + e] = pst * 256u + part[544 + e];
            if (F.bid == 0) for (unsigned p = 0; p < np; ++p) PE[pst + p] = e;
            pst += np; }
        if (F.bid == 0) PE[256] = (int)pst; }
    __syncthreads();
    const int RPW = (MT + F.G - 1) / F.G, r_lo = F.bid * RPW, r_hi = min(r_lo + RPW, MT);
    const TokRec* TR = WSP(TokRec, WS_TOKREC); int* TS = WSP(int, WS_TOKSLOT); int* RT = WSP(int, WS_ROWTOK);
    for (int r = r_lo + F.tid; r < r_hi; r += 512) {
        const TokRec t = TR[r];
        const unsigned s0 = part[576 + (t.e01 & 255u)] + t.lpos0, s1 = part[576 + (t.e01 >> 8)] + t.lpos1;
        RT[s0] = r; RT[s1] = r; TS[2 * r] = (int)s0; TS[2 * r + 1] = (int)s1;
    }
    if (F.bid < 32) { const unsigned e = F.bid, tot = part[512 + e], np = (tot + 255u) >> 8; const unsigned first = part[576 + e] - part[544 + e] + tot, endp = part[576 + e] - part[544 + e] + np * 256u;
        for (unsigned s = first + F.tid; s < endp; s += 512) RT[s] = 0; }
}

__device__ __forceinline__ void p13_ln2(Frame& F, int layer) {
    const int gw = F.vcu * NWAVES + F.wave, NGW = F.G * NWAVES, lane = F.lane;
    const float* MOD = WSP(float, WS_MOD) + (size_t)layer * 2 * 6144; const float* MODN = MOD + 2 * 6144;
    bf16* X = WSP(bf16, WS_X); bf16* XN = WSP(bf16, WS_XN); const bf16* YS = WSP(bf16, WS_YS); const TokRec* TR = WSP(TokRec, WS_TOKREC); const int* TS = WSP(int, WS_TOKSLOT);
    const float* g2 = F.in[I_LN2G] + layer * 1024; const float* b2 = F.in[I_LN2B] + layer * 1024;
    const bool last = (layer == NLAYER - 1);
    const int rend = last ? ML : MT;
    TokRec tn; int s0n = 0, s1n = 0; f32x4 vn[4]; u32x2 yan[4], ybn[4];
    if (gw < rend) { tn = TR[gw]; s0n = TS[2 * gw]; s1n = TS[2 * gw + 1]; row_load_bf16(X + (size_t)gw * 1024, lane, vn);
#pragma unroll
        for (int j = 0; j < 4; ++j) { yan[j] = *(const GAS u32x2*)(YS + (size_t)s0n * 1024 + 4 * lane + 256 * j); ybn[j] = *(const GAS u32x2*)(YS + (size_t)s1n * 1024 + 4 * lane + 256 * j); } }
#pragma unroll 1
    for (int r = gw; r < rend; r += NGW) {
        const bool isc = r >= ML; const float* md = MOD + (isc ? 6144 : 0);
        const TokRec t = tn; f32x4 v[4]; u32x2 yav[4], ybv[4];
#pragma unroll
        for (int j = 0; j < 4; ++j) { v[j] = vn[j]; yav[j] = yan[j]; ybv[j] = ybn[j]; }
        const int rn = r + NGW;
        if (rn < rend) { tn = TR[rn]; s0n = TS[2 * rn]; s1n = TS[2 * rn + 1]; row_load_bf16(X + (size_t)rn * 1024, lane, vn);
#pragma unroll
            for (int j = 0; j < 4; ++j) { yan[j] = *(const GAS u32x2*)(YS + (size_t)s0n * 1024 + 4 * lane + 256 * j); ybn[j] = *(const GAS u32x2*)(YS + (size_t)s1n * 1024 + 4 * lane + 256 * j); } }
#pragma unroll
        for (int j = 0; j < 4; ++j) {
            const u32x2 ya = yav[j], yb = ybv[j];
            f32x4 f; f.x = t.w0 * bflo(ya.x) + t.w1 * bflo(yb.x); f.y = t.w0 * bfhi(ya.x) + t.w1 * bfhi(yb.x); f.z = t.w0 * bflo(ya.y) + t.w1 * bflo(yb.y); f.w = t.w0 * bfhi(ya.y) + t.w1 * bfhi(yb.y);
            v[j] = v[j] * DN_ALPHA + *(const GAS f32x4*)(md + 5120 + 4 * lane + 256 * j) * f;
        }
        row_norm(v);
#pragma unroll
        for (int j = 0; j < 4; ++j) v[j] = v[j] * *(const GAS f32x4*)(g2 + 4 * lane + 256 * j) + *(const GAS f32x4*)(b2 + 4 * lane + 256 * j);
        if (last) {
#pragma unroll
            for (int j = 0; j < 4; ++j) *(GAS f32x4*)(F.out + (size_t)r * 1024 + 4 * lane + 256 * j) = v[j];
        } else {
            row_store_bf16(X + (size_t)r * 1024, lane, v);
            const float* mn = MODN + (isc ? 6144 : 0);
            row_norm(v);
#pragma unroll
            for (int j = 0; j < 4; ++j) v[j] = v[j] * (*(const GAS f32x4*)(mn + 1024 + 4 * lane + 256 * j) + 1.f) + *(const GAS f32x4*)(mn + 4 * lane + 256 * j);
            row_store_bf16(XN + (size_t)r * 1024, lane, v);
        }
    }
}
typedef float f32x4v __attribute__((ext_vector_type(4)));
__device__ __forceinline__ f32x4 ctx_reduce_halves(Frame& F, f32x4 acc) {
    LAS f32x4* red = (LAS f32x4*)F.lds;
    __syncthreads();
    if (F.wave >= 4) red[(F.wave - 4) * 64 + F.lane] = acc;
    __syncthreads();
    if (F.wave < 4) acc += red[F.wave * 64 + F.lane];
    return acc;
}
__device__ __forceinline__ void ctx_branch_item(Frame& F, int item) {
    const int s = item >> 4, ch = item & 15, cg = F.wave & 3, kh = F.wave >> 2, fr = F.lane & 15, fq = F.lane >> 4;
    const int row = ML + 16 * s + fr, col = 64 * ch + 16 * cg;
    const bf16* GATE = WSP(bf16, WS_GATE) + (size_t)row * 4096 + col + 4 * fq;
    f32x4 merged = {0.f, 0.f, 0.f, 0.f};
#pragma unroll 1
    for (int n = 0; n < 4; ++n) {
        const bf16* A = WSP(bf16, WS_ABR) + ((size_t)n * MT + row) * 512 + kh * 256 + 8 * fq;
        const bf16* B = WSP(bf16, WS_WBR) + ((size_t)n * 1024 + col + fr) * 512 + kh * 256 + 8 * fq;
        bf16x8 af[8], bfr[8];
#pragma unroll
        for (int k = 0; k < 8; ++k) { af[k] = *(const GAS bf16x8*)(A + 32 * k); bfr[k] = *(const GAS bf16x8*)(B + 32 * k); }
        const u32x2 gw = *(const GAS u32x2*)(GATE + n * 1024);
        f32x4 acc = {0.f, 0.f, 0.f, 0.f};
#pragma unroll
        for (int k = 0; k < 8; ++k) acc = __builtin_amdgcn_mfma_f32_16x16x32_bf16(bfr[k], af[k], acc, 0, 0, 0);
        f32x4 g; g.x = bflo(gw.x); g.y = bfhi(gw.x); g.z = bflo(gw.y); g.w = bfhi(gw.y);
        merged += g * acc;
    }
    merged = ctx_reduce_halves(F, merged);
    if (F.wave < 4) { u32x2 w; w.x = pk2(merged.x, merged.y); w.y = pk2(merged.z, merged.w); *(GAS u32x2*)(WSP(bf16, WS_MERGED) + (size_t)row * 1024 + col + 4 * fq) = w; }
}
__device__ __forceinline__ void ctx_out_item(Frame& F, int layer, int item) {
    const int s = item >> 4, ch = item & 15, cg = F.wave & 3, kh = F.wave >> 2, fr = F.lane & 15, fq = F.lane >> 4;
    const int row = ML + 16 * s + fr, col = 64 * ch + 16 * cg;
    const bf16* A = WSP(bf16, WS_MERGED) + (size_t)row * 1024 + kh * 512 + 8 * fq;
    const bf16* B = WSP(bf16, WS_WOUT) + (size_t)(col + fr) * 1024 + kh * 512 + 8 * fq;
    f32x4 acc = {0.f, 0.f, 0.f, 0.f};
#pragma unroll 1
    for (int k0 = 0; k0 < 2; ++k0) {
        bf16x8 af[8], bfr[8];
#pragma unroll
        for (int k = 0; k < 8; ++k) { af[k] = *(const GAS bf16x8*)(A + 256 * k0 + 32 * k); bfr[k] = *(const GAS bf16x8*)(B + 256 * k0 + 32 * k); }
#pragma unroll
        for (int k = 0; k < 8; ++k) acc = __builtin_amdgcn_mfma_f32_16x16x32_bf16(bfr[k], af[k], acc, 0, 0, 0);
    }
    acc = ctx_reduce_halves(F, acc);
    if (F.wave < 4) {
        f32x4 x;
        if (layer == 0) x = *(const GAS f32x4*)(F.in[I_CTX] + (size_t)(row - ML) * 1024 + col + 4 * fq);
        else { const u32x2 w = *(const GAS u32x2*)(WSP(bf16, WS_X) + (size_t)row * 1024 + col + 4 * fq); x.x = bflo(w.x); x.y = bfhi(w.x); x.z = bflo(w.y); x.w = bfhi(w.y); }
        const f32x4 g1 = *(const GAS f32x4*)(WSP(float, WS_MOD) + ((size_t)layer * 2 + 1) * 6144 + 2048 + col + 4 * fq);
        const f32x4 o = x * DN_ALPHA + g1 * acc;
        u32x2 ow; ow.x = pk2(o.x, o.y); ow.y = pk2(o.z, o.w);
        *(GAS u32x2*)(WSP(bf16, WS_T1) + (size_t)row * 1024 + col + 4 * fq) = ow;
    }
}
__global__ void __launch_bounds__(NWAVES * 64, 2) fwd_kernel(Args args) {
    extern __shared__ __attribute__((aligned(16))) unsigned char lds_raw[];
    Frame F;
    F.lds = (LAS unsigned char*)lds_raw;
    F.MISC = (volatile LAS unsigned*)(F.lds + MISC_OFF);
    F.tid = threadIdx.x; F.lane = F.tid & 63; F.wave = __builtin_amdgcn_readfirstlane(F.tid >> 6);
    F.G = gridDim.x; F.bid = blockIdx.x; F.vcu = (F.G % 8 == 0) ? (F.bid % 8) * (F.G / 8) + F.bid / 8 : F.bid;
    F.in = args.in; F.ws = args.ws; F.out = args.out;
    for (int u = F.tid; u < (LDS_BYTES - MISC_OFF) / 4; u += NWAVES * 64) F.MISC[u] = 0u;
    __syncthreads();
    XcdBarrier bar = xcd_barrier_post((unsigned*)(F.ws + WS_CTL) + CW_BAR, F.MISC + 8);
#define LAUNDER_PTR(T, dst, src) do { unsigned long long p_ = (unsigned long long)(src); unsigned lo_ = (unsigned)p_, hi_ = (unsigned)(p_ >> 32); asm volatile("" : "+v"(lo_), "+v"(hi_)); lo_ = __builtin_amdgcn_readfirstlane(lo_); hi_ = __builtin_amdgcn_readfirstlane(hi_); (dst) = (T)(((unsigned long long)hi_ << 32) | lo_); } while (0)
#define GRID_BAR() do { XcdBarrier b2_ = bar; LAUNDER_PTR(unsigned*, b2_.bar, bar.bar); b2_.x = xb_xcc_id(); xcd_barrier(b2_); } while (0)
    using namespace pg8;
    LAS unsigned char* ring = F.lds;

#ifndef PH_MASK
#define PH_MASK 0xffffffffu
#endif
#define PH(k) if constexpr (((PH_MASK) >> (k)) & 1u)
#define PHASE_BEGIN() do { F.tid = threadIdx.x; F.bid = blockIdx.x; asm volatile("" : "+v"(F.tid), "+s"(F.bid)); F.vcu = (F.G % 8 == 0) ? (F.bid % 8) * (F.G / 8) + F.bid / 8 : F.bid; LAUNDER_PTR(unsigned char*, F.ws, args.ws); F.in = args.in; F.lane = F.tid & 63; F.wave = __builtin_amdgcn_readfirstlane(F.tid >> 6); } while (0)
#ifndef PROBE_REP
#define PROBE_REP 0u
#endif
#ifndef PROBE_N
#define PROBE_N 3
#endif
#define REPN(k) ((((PROBE_REP) >> (k)) & 1u) ? PROBE_N : 1)
#define REP(k) _Pragma("unroll") for (int rep_ = 0; rep_ < REPN(k); ++rep_)
#define REPU(k) _Pragma("unroll") for (int repu_ = 0; repu_ < REPN(k); ++repu_)
    PH(0) { p0_mods(F); p0_tables(F); }
    GRID_BAR();

#ifndef LAYER_UNROLL
#define LAYER_UNROLL 4
#endif
#pragma unroll LAYER_UNROLL
    for (int layer = 0; layer < NLAYER; ++layer) {
        const bool last = (layer == NLAYER - 1);
        PHASE_BEGIN();
        REP(0) {
        if (layer == 0) { PH(4) { p_xn0(F); } } else { PH(17) { if (rep_ == 0) p13_ln2(F, layer - 1); } }
        PH(1) { p1_convert(F, layer); }
        __syncthreads(); PHASE_BEGIN();
        PH(2) { Gemm g{WSP(bf16_t, WS_W3T) + (size_t)layer * 2048 * 128, WSP(bf16_t, WS_HDN2B) + (size_t)layer * ML * 128, 2048, ML, 128};
          StaticOrder S; S.init(2048, ML, F.G, F.bid); EpiPlain E; E.O = WSP(bf16_t, WS_TAPS); E.ldc = ML;
          gemm_phase<EpiPlain, StaticOrder, true, true>(ring, g, S, E); }
        GRID_BAR(); PHASE_BEGIN();
        }
        REP(2) {
        PH(5) { Gemm g{WSP(bf16_t, WS_XN), WSP(bf16_t, WS_WIN), MT, INCOLS, 1024};
          StaticOrder S; S.init(MT, INCOLS, F.G, F.bid);
          EpiInProj E; E.Q = WSP(bf16_t, WS_Q); E.K = WSP(bf16_t, WS_K); E.V = WSP(bf16_t, WS_V); E.POOL = WSP(bf16_t, WS_POOL); E.HY = WSP(bf16_t, WS_HY); E.SC = WSP(bf16_t, WS_SC); E.GATE = WSP(bf16_t, WS_GATE);
          E.rcos = WSP(float, WS_ROPE); E.rsin = E.rcos + 320 * 16; E.n_lat = ML; E.qscale = QSCALE;
          gemm_phase<EpiInProj, StaticOrder, true, true>(ring, g, S, E); }
        GRID_BAR(); PHASE_BEGIN();
        }
        REP(3) {
        { const int natt = last ? 256 : 260;
          PH(6) REPU(12) {
#pragma unroll 1
          for (int it2 = 0; ; ++it2) {
              int u;
              if (F.G == 256) { if (it2 == 0) u = F.vcu; else if (it2 == 1) u = (natt > 256 && F.vcu >= 252) ? 256 + (255 - F.vcu) : -1; else break; }
              else { u = F.vcu + it2 * F.G; if (u >= natt) break; }
              if (u < 0) continue;
              if (u < 256) attn_unit(F, layer, u & 1, (u >> 1) * 128, true, u >> 1);
              else { const int uc = u - 256; attn_unit(F, layer, uc & 1, ML + (uc >> 1) * 128, false, 0); }
          } }
          const int nblk = last ? 256 : 260;
          PH(7) REP(13) {
#pragma unroll 1
          for (int b = F.vcu; b < nblk; b += F.G) {
              if (b < 256) token_block_item(F, layer, 0, ML, b * 64, WSP(bf16, WS_HT), ML);
              else token_block_item(F, layer, ML, MC, (b - 256) * 64, WSP(bf16, WS_HTC), MC);
          }
          } }
        __syncthreads(); PHASE_BEGIN();
        PH(3) REP(1) {
        ptw_init(F);
#pragma unroll 1
        for (int u = F.vcu; u < 1024; u += F.G) filter_unit(F, u); }
        GRID_BAR(); PHASE_BEGIN();
        }
        REP(4) {
        PH(8) {
        ptw_init(F);
#pragma unroll 1
        for (int u = F.vcu; u < 256; u += F.G) hyena_unit(F, layer, u); }
        PH(9) if (!last) {
#pragma unroll 1
            for (int u = F.vcu; u < 256; u += F.G) hyena_ctx_unit(F, layer, u);
        }
        GRID_BAR(); PHASE_BEGIN();
        }
        REP(6) {
        PH(11) { Gemm g{WSP(bf16_t, WS_ABR), WSP(bf16_t, WS_WBR), 4 * MT, 4096, 512};
          BranchOrder S; S.G = F.G; S.c = F.vcu; S.ntile = (ML / 256) * 4; S.npan = NPANEL;
          EpiBranch E; E.GATE = WSP(bf16_t, WS_GATE); E.MERGED = WSP(bf16_t, WS_MERGED); E.npan = NPANEL;
          gemm_phase<EpiBranch, BranchOrder, true, true>(ring, g, S, E); }
        if (!last) { __syncthreads();
#pragma unroll 1
          for (int it = F.vcu; it < 256; it += F.G) ctx_branch_item(F, it); }
        GRID_BAR(); PHASE_BEGIN();
        }
        REP(7) {
        PH(12) { Gemm g{WSP(bf16_t, WS_MERGED), WSP(bf16_t, WS_WOUT), ML, 1024, 1024};
          StaticOrder S; S.init(ML, 1024, F.G, F.bid);
          EpiOut E; E.xf = layer == 0 ? F.in[I_X] : nullptr; E.xb = WSP(bf16_t, WS_X); E.g1l = WSP(float, WS_MOD) + (size_t)layer * 2 * 6144 + 2048; E.T1 = WSP(bf16_t, WS_T1);
          gemm_phase<EpiOut, StaticOrder, true, true>(ring, g, S, E); }
        if (!last) { __syncthreads();
#pragma unroll 1
          for (int it = F.vcu; it < 256; it += F.G) ctx_out_item(F, layer, it); }
        GRID_BAR(); PHASE_BEGIN();
        }
        REP(8) {
        PH(13) { p9_ln1_router(F, layer); }
        GRID_BAR(); PHASE_BEGIN();
        }
        REP(9) {
        PH(14) { p10_slots_gather(F); }
        GRID_BAR(); PHASE_BEGIN();
        }
        { const int* PE = WSP(int, WS_PANEL); const int npan = PE[256];
          REP(10) {
          PH(15) { LAS int* rowtab = (LAS int*)(F.lds + 131072);
            { const int* RT = WSP(int, WS_ROWTOK);
#pragma unroll 1
              for (int ui = 0; ui < 4; ++ui) { const int L = ui * F.G + F.vcu; if (L < npan * 4 && F.tid < 256) rowtab[ui * 256 + F.tid] = RT[(L >> 2) * 256 + F.tid]; } }
            __syncthreads();
            Gemm g{WSP(bf16_t, WS_HN), WSP(bf16_t, WS_W13), MT, 32 * 1024, 1024};
            ExpertOrder S; S.G = F.G; S.c = F.vcu; S.panel_e = PE; S.npanels = npan; EpiE1 E; E.H = WSP(bf16_t, WS_HS);
            gemm_phase_ga<EpiE1, ExpertOrder, true, true>(ring, g, S, E, rowtab); }
          GRID_BAR(); PHASE_BEGIN();
          }
          REP(11) {
          PH(16) { Gemm g{WSP(bf16_t, WS_HS), WSP(bf16_t, WS_W2), SMAXP * 256, 32 * 1024, 512};
            ExpertOrder S; S.G = F.G; S.c = F.vcu; S.panel_e = PE; S.npanels = npan; EpiE2 E; E.Y = WSP(bf16_t, WS_YS);
            gemm_phase<EpiE2, ExpertOrder, true, true>(ring, g, S, E); }
          GRID_BAR(); PHASE_BEGIN();
          } }
        if (last) { PH(17) { p13_ln2(F, layer); } }
    }
}

extern "C" void kernel_launch(void* const* d_in, const int* in_sizes, int n_in, void* d_out, int out_size, void* d_ws, size_t ws_size, hipStream_t stream) {
    static int grid = 0;
    if (grid == 0) {
        if (n_in != 34 || out_size != ML * DM || ws_size < WS_END) { fprintf(stderr, "kernel_launch: unexpected shapes (n_in %d out %d ws %zu)\n", n_in, out_size, ws_size); grid = -1; return; }
        int dev = 0, cus = 0;
        if (hipGetDevice(&dev) != hipSuccess || hipDeviceGetAttribute(&cus, hipDeviceAttributeMultiprocessorCount, dev) != hipSuccess) { grid = -1; return; }
        if (hipFuncSetAttribute((const void*)fwd_kernel, hipFuncAttributeMaxDynamicSharedMemorySize, LDS_BYTES) != hipSuccess) { fprintf(stderr, "kernel_launch: hipFuncSetAttribute failed\n"); grid = -1; return; }
        int per_cu = 0;
        if (hipOccupancyMaxActiveBlocksPerMultiprocessor(&per_cu, (const void*)fwd_kernel, NWAVES * 64, LDS_BYTES) != hipSuccess || per_cu < 1) fprintf(stderr, "kernel_launch: occupancy query says %d\n", per_cu);
        (void)hipGetLastError();
        grid = cus - (cus % 8);
        if (grid > 256) grid = 256;
    }
    if (grid < 0) return;
    (void)hipMemsetAsync((char*)d_ws + WS_CTL, 0, CTL_ZERO_BYTES, stream);
    Args a{};
    for (int i = 0; i < 34; ++i) a.in[i] = (const float*)d_in[i];
    a.out = (float*)d_out; a.ws = (unsigned char*)d_ws;
    hipLaunchKernelGGL(fwd_kernel, dim3(grid), dim3(NWAVES * 64), LDS_BYTES, stream, a);
}
```

```cpp
#include <hip/hip_runtime.h>
#include <cstdio>
#include <cstdint>

#define GAS __attribute__((address_space(1)))
#define LAS __attribute__((address_space(3)))
typedef unsigned short bf16;
typedef float f32x4 __attribute__((ext_vector_type(4)));
typedef float f32x2 __attribute__((ext_vector_type(2)));
typedef float f32x16 __attribute__((ext_vector_type(16)));
typedef unsigned u32x4 __attribute__((ext_vector_type(4)));
typedef unsigned u32x2 __attribute__((ext_vector_type(2)));
typedef short bf16x8 __attribute__((ext_vector_type(8)));
typedef short s16x4 __attribute__((ext_vector_type(4)));
typedef __bf16 bf16x2_t __attribute__((ext_vector_type(2)));

constexpr int ML = 16384, MC = 256, MT = ML + MC, DM = 1024, NLAYER = 4;
constexpr int NPANEL = MT / 256;
constexpr int INCOLS = 8448;
constexpr int SMAXP = 162;
constexpr float DN_ALPHA = 1.681792830507429f;
constexpr float LN_EPS = 1e-6f;
constexpr float QSCALE = 0.125f * 1.4426950408889634f;
constexpr float LOG2E = 1.4426950408889634f;

constexpr size_t MiB = 1u << 20;
constexpr size_t WS_CTL = 0, CTL_ZERO_BYTES = 1 * MiB;
constexpr size_t WS_MOD = 1 * MiB;
constexpr size_t WS_ROPE = 1 * MiB + 256 * 1024;
constexpr size_t WS_HDN2C = 1 * MiB + 512 * 1024;
constexpr size_t WS_WGCNT = 1 * MiB + 768 * 1024;
constexpr size_t WS_PANEL = 1 * MiB + 832 * 1024;
constexpr size_t WS_TOKREC = 2 * MiB;
constexpr size_t WS_TOKSLOT = 3 * MiB;
constexpr size_t WS_ROWTOK = 3 * MiB + 512 * 1024;
constexpr size_t WS_W3T = 4 * MiB;
constexpr size_t WS_HDN2B = 8 * MiB;
constexpr size_t WS_WIN = 40 * MiB;
constexpr size_t WS_WBR = 57 * MiB;
constexpr size_t WS_WOUT = 61 * MiB;
constexpr size_t WS_W13 = 64 * MiB;
constexpr size_t WS_W2 = 128 * MiB;
constexpr size_t WS_TAPS = 160 * MiB;
constexpr size_t WS_KSPEC = 224 * MiB;
constexpr size_t WS_X = 352 * MiB;
constexpr size_t WS_T1 = 417 * MiB;
constexpr size_t WS_XN = 482 * MiB;
constexpr size_t WS_HN = 515 * MiB;
constexpr size_t WS_R1 = 548 * MiB;
constexpr size_t SZ_Q = (size_t)MT * 512 * 2, SZ_KV = (size_t)MT * 128 * 2, SZ_HY = (size_t)MT * 1536 * 2, SZ_GATE = (size_t)MT * 4096 * 2;
constexpr size_t WS_Q = WS_R1, WS_K = WS_Q + SZ_Q, WS_V = WS_K + SZ_KV, WS_POOL = WS_V + SZ_KV, WS_HY = WS_POOL + SZ_Q, WS_SC = WS_HY + SZ_HY, WS_GATE = WS_SC + SZ_HY;
constexpr size_t WS_ASORT = WS_R1, WS_HS = WS_R1 + 81 * MiB, WS_YS = WS_R1 + 122 * MiB;
constexpr size_t WS_ABR = 817 * MiB;
constexpr size_t WS_HT = 882 * MiB;
constexpr size_t WS_HTC = 930 * MiB;
constexpr size_t WS_YHT = 931 * MiB;
constexpr size_t WS_MERGED = 947 * MiB;
constexpr size_t WS_END = 980 * MiB;
static_assert(WS_GATE + SZ_GATE <= WS_ABR && WS_YS + (size_t)SMAXP * 256 * 1024 * 2 <= WS_ABR && WS_HS + (size_t)SMAXP * 256 * 512 * 2 <= WS_YS && (size_t)SMAXP * 256 * 1024 * 2 <= 81 * MiB, "ws map");
constexpr int CW_BAR = 4096;

constexpr int LDS_BYTES = 163840;
constexpr int MISC_OFF = 161792;
constexpr int NWAVES = 8;

__device__ __forceinline__ unsigned f2bf(float f) { unsigned u = __builtin_bit_cast(unsigned, f); return (u + 0x7fffu + ((u >> 16) & 1u)) >> 16; }
__device__ __forceinline__ unsigned pk2(float lo, float hi) { bf16x2_t b = __builtin_convertvector((f32x2){lo, hi}, bf16x2_t); return __builtin_bit_cast(unsigned, b); }
__device__ __forceinline__ float bf2f(unsigned u) { return __builtin_bit_cast(float, u << 16); }
__device__ __forceinline__ float bflo(unsigned u) { return __builtin_bit_cast(float, u << 16); }
__device__ __forceinline__ float bfhi(unsigned u) { return __builtin_bit_cast(float, u & 0xffff0000u); }
__device__ __forceinline__ float wave_sum(float v) {
#define WS_DPP(x, ctrl, rmask) __builtin_bit_cast(float, __builtin_amdgcn_update_dpp(0, __builtin_bit_cast(int, x), ctrl, rmask, 0xf, false))
    v += WS_DPP(v, 0x111, 0xf);
    v += WS_DPP(v, 0x112, 0xf);
    v += WS_DPP(v, 0x114, 0xf);
    v += WS_DPP(v, 0x118, 0xf);
    v += WS_DPP(v, 0x142, 0xa);
    v += WS_DPP(v, 0x143, 0xc);
#undef WS_DPP
    return __builtin_bit_cast(float, __builtin_amdgcn_readlane(__builtin_bit_cast(int, v), 63));
}
#define LDS_WAIT() asm volatile("s_waitcnt lgkmcnt(0)" ::: "memory")
#define VM_WAIT() asm volatile("s_waitcnt vmcnt(0)" ::: "memory")

namespace pg8 {
#define PG8_LAS __attribute__((address_space(3)))
typedef unsigned short bf16_t;
typedef short bf16x8 __attribute__((ext_vector_type(8)));
typedef float f32x4 __attribute__((ext_vector_type(4)));
typedef unsigned u32x4 __attribute__((ext_vector_type(4)));
constexpr int BM = 256, BK = 64, HALF = 128, HTB = HALF * BK * 2  , STAGE_BYTES = 8 * HTB, NXCD = 8, WGM = 8;

__host__ __device__ __forceinline__ int lds_byte(int r, int c) { const int st = (r >> 4) * 2 + (c >> 5), rr = r & 15, cc = c & 31, ob = rr * 64 + cc * 2; return st * 1024 + (ob ^ (((ob >> 9) & 1) << 5)); }
__host__ __device__ __forceinline__ void stage_rc(int b, int& R, int& C) { const int st = b / 1024, sb = b % 1024, swz = sb ^ (((sb >> 9) & 1) << 5); R = (st >> 1) * 16 + swz / 64; C = (st & 1) * 32 + (swz % 64) / 2; }
__host__ __device__ __forceinline__ int perm32(int rho) { const int n = rho >> 4, i = rho & 15; return 8 * (i >> 2) + 4 * n + (i & 3); }

struct Unit { int pm, pn; };
struct Gemm { const bf16_t* A; const bf16_t* Bt; int M, N, K; };

struct StaticOrder {
    int nM, nN, nwg, G, c;
    __host__ __device__ void init(int M, int N, int G_, int c_) { nM = M / BM; nN = N / BM; nwg = nM * nN; G = G_; c = c_; }
    __host__ __device__ bool next(int i, Unit& u) const {
        const long L = (long)i * G + c; if (L >= nwg) return false;
        int wgid = (int)L; { const int q = nwg / NXCD, r = nwg % NXCD, xcd = wgid % NXCD, off = wgid / NXCD; wgid = (xcd < r ? xcd * (q + 1) : r * (q + 1) + (xcd - r) * q) + off; }
        const int nig = WGM * nN, gid = wgid / nig, fm = gid * WGM, gsz = (nM - fm) < WGM ? (nM - fm) : WGM;
        u.pm = fm + ((wgid % nig) % gsz); u.pn = (wgid % nig) / gsz; return true;
    }
    __device__ __forceinline__ void a_ready(const Unit&) const {}
    __device__ __forceinline__ void done(const Unit&) const {}
};
__device__ __forceinline__ unsigned cvt_pk_bf16(float lo, float hi) { unsigned r; asm volatile("v_cvt_pk_bf16_f32 %0, %1, %2" : "=v"(r) : "v"(lo), "v"(hi)); return r; }
typedef float f32x2 __attribute__((ext_vector_type(2)));
constexpr float DN_ALPHA_C = 1.681792830507429f;
typedef GAS u32x4 gv4u; typedef GAS f32x4 gv4f; typedef GAS u32x2 gv2u;
struct EpiBase { static constexpr bool PERM = true, AFTER_DRAIN = false; __device__ __forceinline__ bool keep(const Unit&) const { return false; } };

struct EpiInProj : EpiBase {
    bf16_t *Q, *K, *V, *POOL, *HY, *SC, *GATE; const float* rcos; const float* rsin; int n_lat; float qscale;
    __device__ __forceinline__ void operator()(f32x4 (&acc)[2][2][4][2], const Unit& u, int wr, int wc, int fr, int fq) const {
        const int row0 = u.pm * BM + wr * 64 + fr;
#pragma unroll
        for (int bj = 0; bj < 2; ++bj) {
            const int ctile = u.pn * BM + bj * HALF;
            bf16_t* base; int ld, coff, mode = 0;
            if (ctile < 512) { base = Q; ld = 512; coff = ctile; mode = 1; }
            else if (ctile < 640) { base = K; ld = 128; coff = ctile - 512; mode = 2; }
            else if (ctile < 768) { base = V; ld = 128; coff = ctile - 640; }
            else if (ctile < 1280) { base = POOL; ld = 512; coff = ctile - 768; }
            else if (ctile < 2816) { base = HY; ld = 1536; coff = ctile - 1280; }
            else if (ctile < 4352) { base = SC; ld = 1536; coff = ctile - 2816; }
            else { base = GATE; ld = 4096; coff = ctile - 4352; }
            const int col = coff + wc * 32 + 8 * fq;
#pragma unroll
            for (int ai = 0; ai < 2; ++ai)
#pragma unroll
                for (int m = 0; m < 4; ++m) {
                    const int row = row0 + ai * HALF + m * 16;
                    f32x4 v0 = acc[ai][bj][m][0], v1 = acc[ai][bj][m][1];
                    if (mode) {
                        if (row < n_lat) {
                            const int pidx = (wc & 1) ? 256 + (row & 63) : (row >> 6);
                            const f32x4 c4 = *(const gv4f*)(rcos + pidx * 16 + 4 * fq), s4 = *(const gv4f*)(rsin + pidx * 16 + 4 * fq);
                            f32x4 a, b;
                            a.x = v0.x * c4.x - v0.y * s4.x; a.y = v0.y * c4.x + v0.x * s4.x; a.z = v0.z * c4.y - v0.w * s4.y; a.w = v0.w * c4.y + v0.z * s4.y;
                            b.x = v1.x * c4.z - v1.y * s4.z; b.y = v1.y * c4.z + v1.x * s4.z; b.z = v1.z * c4.w - v1.w * s4.w; b.w = v1.w * c4.w + v1.z * s4.w;
                            v0 = a; v1 = b;
                        }
                        if (mode == 1) { v0 = v0 * qscale; v1 = v1 * qscale; }
                    }
                    if (ctile >= 4352) {
#pragma unroll
                        for (int e_ = 0; e_ < 4; ++e_) { v0[e_] = __builtin_amdgcn_rcpf(1.f + __expf(-fminf(fmaxf(v0[e_], -30.f), 30.f))); v1[e_] = __builtin_amdgcn_rcpf(1.f + __expf(-fminf(fmaxf(v1[e_], -30.f), 30.f))); }
                    }
                    u32x4 w; w.x = cvt_pk_bf16(v0[0], v0[1]); w.y = cvt_pk_bf16(v0[2], v0[3]); w.z = cvt_pk_bf16(v1[0], v1[1]); w.w = cvt_pk_bf16(v1[2], v1[3]);
                    *(gv4u*)(base + (size_t)row * ld + col) = w;
                }
        }
    }
};
struct EpiPlain : EpiBase {
    bf16_t* O; int ldc;
    __device__ __forceinline__ void operator()(f32x4 (&acc)[2][2][4][2], const Unit& u, int wr, int wc, int fr, int fq) const {
        const int row0 = u.pm * BM + wr * 64 + fr, col0 = u.pn * BM + wc * 32 + 8 * fq;
#pragma unroll
        for (int ai = 0; ai < 2; ++ai)
#pragma unroll
            for (int m = 0; m < 4; ++m)
#pragma unroll
                for (int bj = 0; bj < 2; ++bj) {
                    const f32x4 v0 = acc[ai][bj][m][0], v1 = acc[ai][bj][m][1];
                    u32x4 w; w.x = cvt_pk_bf16(v0[0], v0[1]); w.y = cvt_pk_bf16(v0[2], v0[3]); w.z = cvt_pk_bf16(v1[0], v1[1]); w.w = cvt_pk_bf16(v1[2], v1[3]);
                    *(gv4u*)(O + (size_t)(row0 + ai * HALF + m * 16) * ldc + col0 + bj * HALF) = w;
                }
    }
};
struct EpiBranch {
    static constexpr bool PERM = true, AFTER_DRAIN = false;
    const bf16_t* GATE; bf16_t* MERGED; int npan;
    __device__ __forceinline__ bool keep(const Unit& u) const { return (u.pn >> 2) < 3; }
    __device__ __forceinline__ void operator()(f32x4 (&acc)[2][2][4][2], const Unit& u, int wr, int wc, int fr, int fq) const {
        const int n = u.pn >> 2, pnl = u.pn & 3, pm = u.pm - n * npan;
        const int row0 = pm * BM + wr * 64 + fr, col0 = pnl * BM + wc * 32 + 8 * fq;
#pragma unroll
        for (int ai = 0; ai < 2; ++ai) {
            u32x4 ga[4][2], gb[4][2];
#pragma unroll
            for (int m = 0; m < 4; ++m)
#pragma unroll
                for (int bj = 0; bj < 2; ++bj) { const bf16_t* gp = GATE + (size_t)(row0 + ai * HALF + m * 16) * 4096 + n * 1024 + col0 + bj * HALF;
                    ga[m][bj] = *(const gv4u*)gp; if (n < 3) gb[m][bj] = *(const gv4u*)(gp + 1024); else gb[m][bj] = ga[m][bj]; }
            __builtin_amdgcn_sched_barrier(0);
#pragma unroll
            for (int m = 0; m < 4; ++m)
#pragma unroll
                for (int bj = 0; bj < 2; ++bj) {
                    const int row = row0 + ai * HALF + m * 16, col = col0 + bj * HALF;
                    float sa[8];
#pragma unroll
                    for (int i = 0; i < 4; ++i) { const unsigned w = ga[m][bj][i]; sa[2 * i] = __builtin_bit_cast(float, w << 16); sa[2 * i + 1] = __builtin_bit_cast(float, w & 0xffff0000u); }
                    if (n < 3) {
                        float r[8];
#pragma unroll
                        for (int i = 0; i < 4; ++i) { const unsigned w = gb[m][bj][i]; r[2 * i] = sa[2 * i] * __builtin_amdgcn_rcpf(__builtin_bit_cast(float, w << 16)); r[2 * i + 1] = sa[2 * i + 1] * __builtin_amdgcn_rcpf(__builtin_bit_cast(float, w & 0xffff0000u)); }
                        f32x4& v0 = acc[ai][bj][m][0]; f32x4& v1 = acc[ai][bj][m][1];
                        v0.x *= r[0]; v0.y *= r[1]; v0.z *= r[2]; v0.w *= r[3]; v1.x *= r[4]; v1.y *= r[5]; v1.z *= r[6]; v1.w *= r[7];
                    } else {
                        const f32x4 v0 = acc[ai][bj][m][0], v1 = acc[ai][bj][m][1];
                        u32x4 w; w.x = cvt_pk_bf16(v0[0] * sa[0], v0[1] * sa[1]); w.y = cvt_pk_bf16(v0[2] * sa[2], v0[3] * sa[3]);
                        w.z = cvt_pk_bf16(v1[0] * sa[4], v1[1] * sa[5]); w.w = cvt_pk_bf16(v1[2] * sa[6], v1[3] * sa[7]);
                        *(gv4u*)(MERGED + (size_t)row * 1024 + col) = w;
                    }
                }
        }
    }
};
struct EpiOut : EpiBase {
    const float* xf; const bf16_t* xb; const float* g1l; bf16_t* T1;
    __device__ __forceinline__ void operator()(f32x4 (&acc)[2][2][4][2], const Unit& u, int wr, int wc, int fr, int fq) const {
        const int row0 = u.pm * BM + wr * 64 + fr, col0 = u.pn * BM + wc * 32 + 8 * fq;
#pragma unroll
        for (int bj = 0; bj < 2; ++bj) {
            const int col = col0 + bj * HALF;
            const f32x4 ga = *(const gv4f*)(g1l + col), gb = *(const gv4f*)(g1l + col + 4);
#pragma unroll
            for (int ai = 0; ai < 2; ++ai) {
                f32x4 xa[4], xc[4];
                if (xf) {
#pragma unroll
                    for (int m = 0; m < 4; ++m) { const size_t o = (size_t)(row0 + ai * HALF + m * 16) * 1024 + col; xa[m] = *(const gv4f*)(xf + o); xc[m] = *(const gv4f*)(xf + o + 4); }
                } else {
                    u32x4 w[4];
#pragma unroll
                    for (int m = 0; m < 4; ++m) w[m] = *(const gv4u*)(xb + (size_t)(row0 + ai * HALF + m * 16) * 1024 + col);
#pragma unroll
                    for (int m = 0; m < 4; ++m) {
                        xa[m].x = __builtin_bit_cast(float, w[m].x << 16); xa[m].y = __builtin_bit_cast(float, w[m].x & 0xffff0000u); xa[m].z = __builtin_bit_cast(float, w[m].y << 16); xa[m].w = __builtin_bit_cast(float, w[m].y & 0xffff0000u);
                        xc[m].x = __builtin_bit_cast(float, w[m].z << 16); xc[m].y = __builtin_bit_cast(float, w[m].z & 0xffff0000u); xc[m].z = __builtin_bit_cast(float, w[m].w << 16); xc[m].w = __builtin_bit_cast(float, w[m].w & 0xffff0000u); }
                }
                __builtin_amdgcn_sched_barrier(0);
#pragma unroll
                for (int m = 0; m < 4; ++m) {
                    const int row = row0 + ai * HALF + m * 16;
                    const f32x4 oa = xa[m] * DN_ALPHA_C + ga * acc[ai][bj][m][0], ob = xc[m] * DN_ALPHA_C + gb * acc[ai][bj][m][1];
                    u32x4 o; o.x = cvt_pk_bf16(oa[0], oa[1]); o.y = cvt_pk_bf16(oa[2], oa[3]); o.z = cvt_pk_bf16(ob[0], ob[1]); o.w = cvt_pk_bf16(ob[2], ob[3]);
                    *(gv4u*)(T1 + (size_t)row * 1024 + col) = o;
                }
            }
        }
    }
};
struct EpiE1 : EpiBase {
    bf16_t* H;
    __device__ __forceinline__ void operator()(f32x4 (&acc)[2][2][4][2], const Unit& u, int wr, int wc, int fr, int fq) const {
        const int pnl = u.pn & 3, row0 = u.pm * BM + wr * 64 + fr, hc0 = pnl * 128 + wc * 16 + 4 * fq;
#pragma unroll
        for (int ai = 0; ai < 2; ++ai)
#pragma unroll
            for (int m = 0; m < 4; ++m)
#pragma unroll
                for (int bj = 0; bj < 2; ++bj) {
                    const f32x4 v0 = acc[ai][bj][m][0], v1 = acc[ai][bj][m][1];
                    const float h0 = v0.x * __builtin_amdgcn_rcpf(1.f + __expf(-v0.x)) * v0.y, h1 = v0.z * __builtin_amdgcn_rcpf(1.f + __expf(-v0.z)) * v0.w;
                    const float h2 = v1.x * __builtin_amdgcn_rcpf(1.f + __expf(-v1.x)) * v1.y, h3 = v1.z * __builtin_amdgcn_rcpf(1.f + __expf(-v1.z)) * v1.w;
                    u32x2 w; w.x = cvt_pk_bf16(h0, h1); w.y = cvt_pk_bf16(h2, h3);
                    *(gv2u*)(H + (size_t)(row0 + ai * HALF + m * 16) * 512 + hc0 + bj * 64) = w;
                }
    }
};
struct EpiE2 : EpiBase {
    bf16_t* Y;
    __device__ __forceinline__ void operator()(f32x4 (&acc)[2][2][4][2], const Unit& u, int wr, int wc, int fr, int fq) const {
        const int pnl = u.pn & 3, row0 = u.pm * BM + wr * 64 + fr, col0 = pnl * BM + wc * 32 + 8 * fq;
#pragma unroll
        for (int ai = 0; ai < 2; ++ai)
#pragma unroll
            for (int m = 0; m < 4; ++m)
#pragma unroll
                for (int bj = 0; bj < 2; ++bj) {
                    const f32x4 v0 = acc[ai][bj][m][0], v1 = acc[ai][bj][m][1];
                    u32x4 w; w.x = cvt_pk_bf16(v0[0], v0[1]); w.y = cvt_pk_bf16(v0[2], v0[3]); w.z = cvt_pk_bf16(v1[0], v1[1]); w.w = cvt_pk_bf16(v1[2], v1[3]);
                    *(gv4u*)(Y + (size_t)(row0 + ai * HALF + m * 16) * 1024 + col0 + bj * HALF) = w;
                }
    }
};
struct HooksNone { __device__ __forceinline__ void a_ready(const Unit&) const {} __device__ __forceinline__ void done(const Unit&) const {} };
struct BranchOrder : HooksNone {
    int G, c, ntile, npan;
    __device__ __forceinline__ bool next(int i, Unit& u) const { const int T = (i >> 2) * G + c; if (T >= ntile) return false; const int n = i & 3; u.pm = n * npan + (T >> 2); u.pn = n * 4 + (T & 3); return true; }
};
struct ExpertOrder : HooksNone {
    int G, c; const int* panel_e; int npanels;
    __device__ __forceinline__ bool next(int i, Unit& u) const { const int L = i * G + c; if (L >= npanels * 4) return false; const int p = L >> 2; u.pm = p; u.pn = panel_e[p] * 4 + (L & 3); return true; }
};
template <class Epi, class Sched, bool ALIGN_EPI = false, bool SP2 = false>
__device__ __forceinline__ void gemm_phase(PG8_LAS unsigned char* lds, const Gemm g, const Sched& S, const Epi& E) {
    int tid_ = threadIdx.x; asm volatile("" : "+v"(tid_));
    const int tid = tid_, wid = __builtin_amdgcn_readfirstlane(tid >> 6), lane = tid & 63, wr = wid >> 2, wc = wid & 3, fr = lane & 15, fq = lane >> 4;
    const int K = g.K, nt = K / BK;
    unsigned voffA[2], voffB[2];
#pragma unroll
    for (int i = 0; i < 2; ++i) { int R, C; stage_rc(tid * 16 + i * 8192, R, C); const int Rb = Epi::PERM ? ((R & ~31) + perm32(R & 31)) : R;
        voffA[i] = (unsigned)(R * K + C) * 2u; voffB[i] = (unsigned)(Rb * K + C) * 2u; }
    const size_t kstep = (size_t)(BK * 2);
    const size_t hstep = (size_t)HALF * K * 2;
    const size_t tstep = 2 * hstep;
    const unsigned ldsw = (unsigned)wid * 1024u;
    const int aoff = lds_byte(wr * 64 + fr, fq * 8), boff = lds_byte(wc * 32 + fr, fq * 8);
#define PG8_SA(b, h) (((b) * 2 + (h)) * HTB)
#define PG8_SB(b, h) ((4 + (b) * 2 + (h)) * HTB)
#define PG8_STAGE(bufoff, gbase, voff) do { _Pragma("unroll") for (int _i = 0; _i < 2; ++_i) \
        __builtin_amdgcn_global_load_lds((const unsigned*)((const char*)(gbase) + (voff)[_i]), (PG8_LAS unsigned*)(lds + (bufoff) + ldsw + _i * 8192), 16, 0, 0); } while (0)
#define PG8_LDA(dst, b, h) do { _Pragma("unroll") for (int m = 0; m < 4; ++m) _Pragma("unroll") for (int k = 0; k < 2; ++k) dst[m][k] = *(const PG8_LAS bf16x8*)(lds + PG8_SA(b, h) + aoff + m * 2048 + k * 1024); } while (0)
#define PG8_LDB(dst, b, h) do { _Pragma("unroll") for (int n = 0; n < 2; ++n) _Pragma("unroll") for (int k = 0; k < 2; ++k) dst[n][k] = *(const PG8_LAS bf16x8*)(lds + PG8_SB(b, h) + boff + n * 2048 + k * 1024); } while (0)
#define PG8_MMA(ai, bj, At, Bt) do { __builtin_amdgcn_s_setprio(1); _Pragma("unroll") for (int m = 0; m < 4; ++m) _Pragma("unroll") for (int n = 0; n < 2; ++n) _Pragma("unroll") for (int k = 0; k < 2; ++k) \
        acc[ai][bj][m][n] = __builtin_amdgcn_mfma_f32_16x16x32_bf16(Bt[n][k], At[m][k], acc[ai][bj][m][n], 0, 0, 0); __builtin_amdgcn_s_setprio(0); } while (0)
#define PG8_WAIT_V(n) asm volatile("s_waitcnt vmcnt(" #n ")" ::: "memory")
#define PG8_WAIT_L(n) asm volatile("s_waitcnt lgkmcnt(" #n ")" ::: "memory")
#define PG8_BAR __builtin_amdgcn_s_barrier()
#define PG8_SCHED __builtin_amdgcn_sched_barrier(0)
    Unit cur, nxt; int ui = 0;
    if (!S.next(0, cur)) return;
    f32x4 acc[2][2][4][2];
#pragma unroll
    for (int a = 0; a < 2; ++a)
#pragma unroll
        for (int b = 0; b < 2; ++b)
#pragma unroll
            for (int m = 0; m < 4; ++m)
#pragma unroll
                for (int n = 0; n < 2; ++n) acc[a][b][m][n] = (f32x4){0.f, 0.f, 0.f, 0.f};
    bf16x8 At[4][2], B0[2][2], B1[2][2];
    const char* cA = (const char*)g.A + (size_t)cur.pm * tstep; const char* cB = (const char*)g.Bt + (size_t)cur.pn * tstep;
    S.a_ready(cur);
    if constexpr (SP2) {
        PG8_STAGE(PG8_SB(0, 0), cB, voffB); PG8_STAGE(PG8_SB(0, 1), cB + hstep, voffB); PG8_STAGE(PG8_SA(0, 0), cA, voffA); PG8_STAGE(PG8_SA(0, 1), cA + hstep, voffA);
        if (wr == 1) PG8_BAR;
        PG8_WAIT_V(2); PG8_BAR;
        PG8_STAGE(PG8_SB(1, 0), cB + kstep, voffB); PG8_STAGE(PG8_SA(1, 0), cA + kstep, voffA); PG8_STAGE(PG8_SB(1, 1), cB + hstep + kstep, voffB);
        PG8_WAIT_V(6); PG8_BAR;
    } else {
        PG8_STAGE(PG8_SB(0, 0), cB, voffB); PG8_STAGE(PG8_SA(0, 0), cA, voffA); PG8_STAGE(PG8_SB(0, 1), cB + hstep, voffB); PG8_STAGE(PG8_SA(0, 1), cA + hstep, voffA);
        if (wr == 1) PG8_BAR;
        PG8_WAIT_V(4); PG8_BAR;
        PG8_STAGE(PG8_SB(1, 0), cB + kstep, voffB); PG8_STAGE(PG8_SA(1, 0), cA + kstep, voffA); PG8_STAGE(PG8_SB(1, 1), cB + hstep + kstep, voffB);
        PG8_WAIT_V(6); PG8_BAR;
    }
    for (;;) {
        const bool has_next = S.next(ui + 1, nxt);
        const char* nA = has_next ? (const char*)g.A + (size_t)nxt.pm * tstep : cA; const char* nB = has_next ? (const char*)g.Bt + (size_t)nxt.pn * tstep : cB;
#pragma unroll 1
        for (int t = 0; t < nt; t += 2) {
            const bool last = (t == nt - 2);
            const char* a1 = cA + (size_t)(t + 1) * kstep;
            const char* a2 = last ? nA : cA + (size_t)(t + 2) * kstep; const char* b2 = last ? nB : cB + (size_t)(t + 2) * kstep;
            const char* a3 = a2 + kstep; const char* b3 = b2 + kstep;
            if (last && has_next) S.a_ready(nxt);
            if constexpr (SP2) {
            PG8_LDB(B0, 0, 0); PG8_LDB(B1, 0, 1); PG8_SCHED; PG8_LDA(At, 0, 0); PG8_STAGE(PG8_SA(1, 1), a1 + hstep, voffA);
            PG8_WAIT_V(8); PG8_WAIT_L(0); PG8_BAR; PG8_MMA(0, 0, At, B0); PG8_MMA(0, 1, At, B1); PG8_BAR; PG8_SCHED;
            PG8_LDA(At, 0, 1); PG8_STAGE(PG8_SB(0, 0), b2, voffB); PG8_STAGE(PG8_SB(0, 1), b2 + hstep, voffB); PG8_STAGE(PG8_SA(0, 0), a2, voffA);
            PG8_WAIT_V(8); PG8_WAIT_L(0); PG8_BAR; PG8_MMA(1, 0, At, B0); PG8_MMA(1, 1, At, B1); PG8_BAR; PG8_SCHED;
            PG8_LDB(B0, 1, 0); PG8_LDB(B1, 1, 1); PG8_SCHED; PG8_LDA(At, 1, 0); PG8_STAGE(PG8_SA(0, 1), a2 + hstep, voffA);
            PG8_WAIT_V(8); PG8_WAIT_L(0); PG8_BAR; PG8_MMA(0, 0, At, B0); PG8_MMA(0, 1, At, B1); PG8_BAR; PG8_SCHED;
            PG8_LDA(At, 1, 1); PG8_STAGE(PG8_SB(1, 0), b3, voffB); PG8_STAGE(PG8_SB(1, 1), b3 + hstep, voffB); PG8_STAGE(PG8_SA(1, 0), a3, voffA);
            PG8_WAIT_V(8); PG8_WAIT_L(0); PG8_BAR; PG8_MMA(1, 0, At, B0); PG8_MMA(1, 1, At, B1); PG8_BAR; PG8_SCHED;
            } else {
            PG8_LDB(B0, 0, 0); PG8_SCHED; PG8_LDA(At, 0, 0); PG8_STAGE(PG8_SA(1, 1), a1 + hstep, voffA);
            PG8_WAIT_L(8); PG8_BAR; PG8_WAIT_L(0); PG8_MMA(0, 0, At, B0); PG8_BAR; PG8_SCHED;
            PG8_LDB(B1, 0, 1); PG8_STAGE(PG8_SB(0, 0), b2, voffB);
            PG8_BAR; PG8_WAIT_L(0); PG8_MMA(0, 1, At, B1); PG8_BAR;
            PG8_LDA(At, 0, 1); PG8_STAGE(PG8_SA(0, 0), a2, voffA);
            PG8_BAR; PG8_WAIT_L(0); PG8_MMA(1, 0, At, B0); PG8_BAR; PG8_SCHED;
            PG8_STAGE(PG8_SB(0, 1), b2 + hstep, voffB);
            PG8_WAIT_V(6); PG8_BAR; PG8_MMA(1, 1, At, B1); PG8_BAR;
            PG8_LDB(B0, 1, 0); PG8_SCHED; PG8_LDA(At, 1, 0); PG8_STAGE(PG8_SA(0, 1), a2 + hstep, voffA);
            PG8_WAIT_L(8); PG8_BAR; PG8_WAIT_L(0); PG8_MMA(0, 0, At, B0); PG8_BAR; PG8_SCHED;
            PG8_LDB(B1, 1, 1); PG8_STAGE(PG8_SB(1, 0), b3, voffB);
            PG8_BAR; PG8_WAIT_L(0); PG8_MMA(0, 1, At, B1); PG8_BAR;
            PG8_LDA(At, 1, 1); PG8_STAGE(PG8_SA(1, 0), a3, voffA);
            PG8_BAR; PG8_WAIT_L(0); PG8_MMA(1, 0, At, B0); PG8_BAR; PG8_SCHED;
            PG8_STAGE(PG8_SB(1, 1), b3 + hstep, voffB);
            PG8_WAIT_V(6); PG8_BAR; PG8_MMA(1, 1, At, B1); PG8_BAR;
            }
        }
        if constexpr (ALIGN_EPI) { if (wr == 0) PG8_BAR; }
        if constexpr (!Epi::AFTER_DRAIN) { E(acc, cur, wr, wc, fr, fq); S.done(cur); }
        if (!has_next) break;
        if (!E.keep(cur)) {
#pragma unroll
        for (int a = 0; a < 2; ++a)
#pragma unroll
            for (int b = 0; b < 2; ++b)
#pragma unroll
                for (int m = 0; m < 4; ++m)
#pragma unroll
                    for (int n = 0; n < 2; ++n) acc[a][b][m][n] = (f32x4){0.f, 0.f, 0.f, 0.f};
        }
        cur = nxt; cA = nA; cB = nB; ++ui;
        if constexpr (ALIGN_EPI) { if (wr == 1) PG8_BAR; }
    }
    PG8_WAIT_V(0);
    if constexpr (!ALIGN_EPI) { if (wr == 0) PG8_BAR; }
    PG8_BAR;
    if constexpr (Epi::AFTER_DRAIN) { E.fused(acc, cur, wr, wc, fr, fq, lds, wid, lane); S.done(cur); }
#undef PG8_SA
#undef PG8_SB
#undef PG8_STAGE
#undef PG8_LDA
#undef PG8_LDB
#undef PG8_MMA
#undef PG8_WAIT_V
#undef PG8_WAIT_L
#undef PG8_BAR
#undef PG8_SCHED
}
template <class Epi, class Sched, bool ALIGN_EPI = false, bool SP2 = false>
__device__ __forceinline__ void gemm_phase_ga(PG8_LAS unsigned char* lds, const Gemm g, const Sched& S, const Epi& E, const PG8_LAS int* rowtab) {
    int tid_ = threadIdx.x; asm volatile("" : "+v"(tid_));
    const int tid = tid_, wid = __builtin_amdgcn_readfirstlane(tid >> 6), lane = tid & 63, wr = wid >> 2, wc = wid & 3, fr = lane & 15, fq = lane >> 4;
    const int K = g.K, nt = K / BK;
    unsigned voffA[2], voffB[2]; int rowA[2];
#pragma unroll
    for (int i = 0; i < 2; ++i) { int R, C; stage_rc(tid * 16 + i * 8192, R, C); const int Rb = Epi::PERM ? ((R & ~31) + perm32(R & 31)) : R;
        voffA[i] = (unsigned)C * 2u; rowA[i] = R; voffB[i] = (unsigned)(Rb * K + C) * 2u; }
    const size_t kstep = (size_t)(BK * 2);
    const size_t hstep = (size_t)HALF * K * 2;
    const size_t tstep = 2 * hstep;
    const unsigned ldsw = (unsigned)wid * 1024u;
    const int aoff = lds_byte(wr * 64 + fr, fq * 8), boff = lds_byte(wc * 32 + fr, fq * 8);
#define PG8_SA(b, h) (((b) * 2 + (h)) * HTB)
#define PG8_SB(b, h) ((4 + (b) * 2 + (h)) * HTB)
#define PG8_STAGE(bufoff, gbase, voff) do { _Pragma("unroll") for (int _i = 0; _i < 2; ++_i) \
        __builtin_amdgcn_global_load_lds((const unsigned*)((const char*)(gbase) + (voff)[_i]), (PG8_LAS unsigned*)(lds + (bufoff) + ldsw + _i * 8192), 16, 0, 0); } while (0)
#define PG8_LDA(dst, b, h) do { _Pragma("unroll") for (int m = 0; m < 4; ++m) _Pragma("unroll") for (int k = 0; k < 2; ++k) dst[m][k] = *(const PG8_LAS bf16x8*)(lds + PG8_SA(b, h) + aoff + m * 2048 + k * 1024); } while (0)
#define PG8_LDB(dst, b, h) do { _Pragma("unroll") for (int n = 0; n < 2; ++n) _Pragma("unroll") for (int k = 0; k < 2; ++k) dst[n][k] = *(const PG8_LAS bf16x8*)(lds + PG8_SB(b, h) + boff + n * 2048 + k * 1024); } while (0)
#define PG8_MMA(ai, bj, At, Bt) do { __builtin_amdgcn_s_setprio(1); _Pragma("unroll") for (int m = 0; m < 4; ++m) _Pragma("unroll") for (int n = 0; n < 2; ++n) _Pragma("unroll") for (int k = 0; k < 2; ++k) \
        acc[ai][bj][m][n] = __builtin_amdgcn_mfma_f32_16x16x32_bf16(Bt[n][k], At[m][k], acc[ai][bj][m][n], 0, 0, 0); __builtin_amdgcn_s_setprio(0); } while (0)
#define PG8_WAIT_V(n) asm volatile("s_waitcnt vmcnt(" #n ")" ::: "memory")
#define PG8_WAIT_L(n) asm volatile("s_waitcnt lgkmcnt(" #n ")" ::: "memory")
#define PG8_BAR __builtin_amdgcn_s_barrier()
#define PG8_SCHED __builtin_amdgcn_sched_barrier(0)
    Unit cur, nxt; int ui = 0;
    if (!S.next(0, cur)) return;
    f32x4 acc[2][2][4][2];
#pragma unroll
    for (int a = 0; a < 2; ++a)
#pragma unroll
        for (int b = 0; b < 2; ++b)
#pragma unroll
            for (int m = 0; m < 4; ++m)
#pragma unroll
                for (int n = 0; n < 2; ++n) acc[a][b][m][n] = (f32x4){0.f, 0.f, 0.f, 0.f};
    bf16x8 At[4][2], B0[2][2], B1[2][2];
    const char* cA = (const char*)g.A; const char* cB = (const char*)g.Bt + (size_t)cur.pn * tstep;
    unsigned vc0[2], vc1[2], vn0[2], vn1[2];
#define PG8_GOFF(dst0, dst1, u_) do { _Pragma("unroll") for (int _i = 0; _i < 2; ++_i) { dst0[_i] = (unsigned)rowtab[(u_) * 256 + rowA[_i]] * (unsigned)(K * 2) + voffA[_i]; dst1[_i] = (unsigned)rowtab[(u_) * 256 + 128 + rowA[_i]] * (unsigned)(K * 2) + voffA[_i]; } } while (0)
    PG8_GOFF(vc0, vc1, 0); vn0[0] = vc0[0]; vn0[1] = vc0[1]; vn1[0] = vc1[0]; vn1[1] = vc1[1];
    S.a_ready(cur);
    if constexpr (SP2) {
        PG8_STAGE(PG8_SB(0, 0), cB, voffB); PG8_STAGE(PG8_SB(0, 1), cB + hstep, voffB); PG8_STAGE(PG8_SA(0, 0), cA, vc0); PG8_STAGE(PG8_SA(0, 1), cA, vc1);
        if (wr == 1) PG8_BAR;
        PG8_WAIT_V(2); PG8_BAR;
        PG8_STAGE(PG8_SB(1, 0), cB + kstep, voffB); PG8_STAGE(PG8_SA(1, 0), cA + kstep, vc0); PG8_STAGE(PG8_SB(1, 1), cB + hstep + kstep, voffB);
        PG8_WAIT_V(6); PG8_BAR;
    } else {
        PG8_STAGE(PG8_SB(0, 0), cB, voffB); PG8_STAGE(PG8_SA(0, 0), cA, voffA); PG8_STAGE(PG8_SB(0, 1), cB + hstep, voffB); PG8_STAGE(PG8_SA(0, 1), cA + hstep, voffA);
        if (wr == 1) PG8_BAR;
        PG8_WAIT_V(4); PG8_BAR;
        PG8_STAGE(PG8_SB(1, 0), cB + kstep, voffB); PG8_STAGE(PG8_SA(1, 0), cA + kstep, voffA); PG8_STAGE(PG8_SB(1, 1), cB + hstep + kstep, voffB);
        PG8_WAIT_V(6); PG8_BAR;
    }
    for (;;) {
        const bool has_next = S.next(ui + 1, nxt);
        const char* nA = cA; const char* nB = has_next ? (const char*)g.Bt + (size_t)nxt.pn * tstep : cB;
        if (has_next) PG8_GOFF(vn0, vn1, ui + 1);
#pragma unroll 1
        for (int t = 0; t < nt; t += 2) {
            const bool last = (t == nt - 2);
            const char* a1 = cA + (size_t)(t + 1) * kstep;
            const char* a2 = last ? nA : cA + (size_t)(t + 2) * kstep; const char* b2 = last ? nB : cB + (size_t)(t + 2) * kstep;
            const char* a3 = a2 + kstep; const char* b3 = b2 + kstep;
            unsigned s0[2], s1[2];
#pragma unroll
            for (int _i = 0; _i < 2; ++_i) { s0[_i] = last ? vn0[_i] : vc0[_i]; s1[_i] = last ? vn1[_i] : vc1[_i]; }
            if (last && has_next) S.a_ready(nxt);
            if constexpr (SP2) {
            PG8_LDB(B0, 0, 0); PG8_LDB(B1, 0, 1); PG8_SCHED; PG8_LDA(At, 0, 0); PG8_STAGE(PG8_SA(1, 1), a1, vc1);
            PG8_WAIT_V(8); PG8_WAIT_L(0); PG8_BAR; PG8_MMA(0, 0, At, B0); PG8_MMA(0, 1, At, B1); PG8_BAR; PG8_SCHED;
            PG8_LDA(At, 0, 1); PG8_STAGE(PG8_SB(0, 0), b2, voffB); PG8_STAGE(PG8_SB(0, 1), b2 + hstep, voffB); PG8_STAGE(PG8_SA(0, 0), a2, s0);
            PG8_WAIT_V(8); PG8_WAIT_L(0); PG8_BAR; PG8_MMA(1, 0, At, B0); PG8_MMA(1, 1, At, B1); PG8_BAR; PG8_SCHED;
            PG8_LDB(B0, 1, 0); PG8_LDB(B1, 1, 1); PG8_SCHED; PG8_LDA(At, 1, 0); PG8_STAGE(PG8_SA(0, 1), a2, s1);
            PG8_WAIT_V(8); PG8_WAIT_L(0); PG8_BAR; PG8_MMA(0, 0, At, B0); PG8_MMA(0, 1, At, B1); PG8_BAR; PG8_SCHED;
            PG8_LDA(At, 1, 1); PG8_STAGE(PG8_SB(1, 0), b3, voffB); PG8_STAGE(PG8_SB(1, 1), b3 + hstep, voffB); PG8_STAGE(PG8_SA(1, 0), a3, s0);
            PG8_WAIT_V(8); PG8_WAIT_L(0); PG8_BAR; PG8_MMA(1, 0, At, B0); PG8_MMA(1, 1, At, B1); PG8_BAR; PG8_SCHED;
            } else {
            PG8_LDB(B0, 0, 0); PG8_SCHED; PG8_LDA(At, 0, 0); PG8_STAGE(PG8_SA(1, 1), a1 + hstep, voffA);
            PG8_WAIT_L(8); PG8_BAR; PG8_WAIT_L(0); PG8_MMA(0, 0, At, B0); PG8_BAR; PG8_SCHED;
            PG8_LDB(B1, 0, 1); PG8_STAGE(PG8_SB(0, 0), b2, voffB);
            PG8_BAR; PG8_WAIT_L(0); PG8_MMA(0, 1, At, B1); PG8_BAR;
            PG8_LDA(At, 0, 1); PG8_STAGE(PG8_SA(0, 0), a2, voffA);
            PG8_BAR; PG8_WAIT_L(0); PG8_MMA(1, 0, At, B0); PG8_BAR; PG8_SCHED;
            PG8_STAGE(PG8_SB(0, 1), b2 + hstep, voffB);
            PG8_WAIT_V(6); PG8_BAR; PG8_MMA(1, 1, At, B1); PG8_BAR;
            PG8_LDB(B0, 1, 0); PG8_SCHED; PG8_LDA(At, 1, 0); PG8_STAGE(PG8_SA(0, 1), a2 + hstep, voffA);
            PG8_WAIT_L(8); PG8_BAR; PG8_WAIT_L(0); PG8_MMA(0, 0, At, B0); PG8_BAR; PG8_SCHED;
            PG8_LDB(B1, 1, 1); PG8_STAGE(PG8_SB(1, 0), b3, voffB);
            PG8_BAR; PG8_WAIT_L(0); PG8_MMA(0, 1, At, B1); PG8_BAR;
            PG8_LDA(At, 1, 1); PG8_STAGE(PG8_SA(1, 0), a3, voffA);
            PG8_BAR; PG8_WAIT_L(0); PG8_MMA(1, 0, At, B0); PG8_BAR; PG8_SCHED;
            PG8_STAGE(PG8_SB(1, 1), b3 + hstep, voffB);
            PG8_WAIT_V(6); PG8_BAR; PG8_MMA(1, 1, At, B1); PG8_BAR;
            }
        }
        if constexpr (ALIGN_EPI) { if (wr == 0) PG8_BAR; }
        if constexpr (!Epi::AFTER_DRAIN) { E(acc, cur, wr, wc, fr, fq); S.done(cur); }
        if (!has_next) break;
        if (!E.keep(cur)) {
#pragma unroll
        for (int a = 0; a < 2; ++a)
#pragma unroll
            for (int b = 0; b < 2; ++b)
#pragma unroll
                for (int m = 0; m < 4; ++m)
#pragma unroll
                    for (int n = 0; n < 2; ++n) acc[a][b][m][n] = (f32x4){0.f, 0.f, 0.f, 0.f};
        }
        cur = nxt; cA = nA; cB = nB; ++ui;
        vc0[0] = vn0[0]; vc0[1] = vn0[1]; vc1[0] = vn1[0]; vc1[1] = vn1[1];
        if constexpr (ALIGN_EPI) { if (wr == 1) PG8_BAR; }
    }
    PG8_WAIT_V(0);
    if constexpr (!ALIGN_EPI) { if (wr == 0) PG8_BAR; }
    PG8_BAR;
    if constexpr (Epi::AFTER_DRAIN) { E.fused(acc, cur, wr, wc, fr, fq, lds, wid, lane); S.done(cur); }
#undef PG8_SA
#undef PG8_SB
#undef PG8_STAGE
#undef PG8_LDA
#undef PG8_LDB
#undef PG8_MMA
#undef PG8_WAIT_V
#undef PG8_WAIT_L
#undef PG8_BAR
#undef PG8_SCHED
#undef PG8_GOFF
}
}

#define XB_TMO      128
#define XB_XCNT(j)  (256  + 64 * (j))
#define XB_XSUB(j)  (1280 + 64 * (j))
#define XB_XGEN(j)  (2304 + 64 * (j))
#define XB_TOP      3328
#define XB_TOPGEN   3392
#define XCD_BAR_WORDS 3456
#define XB_SPIN_CAP (1u << 18)

__device__ __forceinline__ unsigned xb_ld(unsigned* p)              { return __hip_atomic_load(p, __ATOMIC_RELAXED, __HIP_MEMORY_SCOPE_AGENT); }
__device__ __forceinline__ unsigned xb_add(unsigned* p, unsigned v) { return __hip_atomic_fetch_add(p, v, __ATOMIC_RELAXED, __HIP_MEMORY_SCOPE_AGENT); }
__device__ __forceinline__ unsigned xb_xcc_id() { return (unsigned)__builtin_amdgcn_s_getreg((3 << 11) | 20) & 0xFu; }
#define XB_SPIN(cond, bar) do { unsigned _sp = 0; while (cond) { __builtin_amdgcn_s_sleep(1); \
    if ((++_sp & 255u) == 0u) { if (xb_ld(&(bar)[XB_TMO])) break; if (_sp > XB_SPIN_CAP) { atomicAdd(&(bar)[XB_TMO], 1u); break; } } } } while (0)

struct XcdBarrier {
    unsigned* bar; unsigned x;
    volatile LAS unsigned* st;
};

__device__ __forceinline__ XcdBarrier xcd_barrier_post(unsigned* bar, volatile LAS unsigned* st) {
    XcdBarrier b; b.bar = bar; b.x = xb_xcc_id(); b.st = st;
    if (threadIdx.x == 0) (void)xb_add(&bar[XB_XCNT(b.x)], 1u);
    return b;
}
__device__ __forceinline__ void xcd_barrier_complete(unsigned* bar, unsigned x, unsigned& nloc, unsigned& nx) {
    const unsigned G = gridDim.x * gridDim.y * gridDim.z;
    unsigned sum, cnt, mine, sp = 0u;
    for (;;) {
        sum = 0u; cnt = 0u; mine = 0u;
#pragma unroll
        for (unsigned j = 0; j < 16; ++j) { const unsigned c = xb_ld(&bar[XB_XCNT(j)]); sum += c; cnt += (c > 0u) ? 1u : 0u; mine = (j == x) ? c : mine; }
        if (sum == G) break;
        __builtin_amdgcn_s_sleep(1);
        if ((++sp & 255u) == 0u) { if (xb_ld(&bar[XB_TMO])) break; if (sp > XB_SPIN_CAP) { atomicAdd(&bar[XB_TMO], 1u); break; } }
    }
    nloc = mine > 0u ? mine : 1u; nx = cnt > 0u ? cnt : 1u;
}

__device__ __forceinline__ void xcd_barrier(const XcdBarrier& b) {
    asm volatile("s_waitcnt vmcnt(0)" ::: "memory");
    __syncthreads();
    if (threadIdx.x == 0) {
        unsigned* bar = b.bar;
        __builtin_amdgcn_s_waitcnt(0);
        unsigned nloc = b.st[0], nx = b.st[1];
        if (nloc == 0u) { xcd_barrier_complete(bar, b.x, nloc, nx); b.st[0] = nloc; b.st[1] = nx; }
        const unsigned old = xb_add(&bar[XB_XSUB(b.x)], 1u);
        const unsigned gen = old / nloc;
        if (old + 1u == (gen + 1u) * nloc) {
            __builtin_amdgcn_fence(__ATOMIC_RELEASE, "agent");
            asm volatile("s_waitcnt vmcnt(0)" ::: "memory");
            const unsigned og = xb_add(&bar[XB_TOP], 1u);
            const unsigned tg = og / nx;
            if (og + 1u == (tg + 1u) * nx) xb_add(&bar[XB_TOPGEN], 1u);
            else XB_SPIN(xb_ld(&bar[XB_TOPGEN]) == tg, bar);
            __builtin_amdgcn_fence(__ATOMIC_ACQUIRE, "agent");
            xb_add(&bar[XB_XGEN(b.x)], 1u);
            asm volatile("s_waitcnt vmcnt(0)" ::: "memory");
        } else {
            XB_SPIN(xb_ld(&bar[XB_XGEN(b.x)]) == gen, bar);
            __builtin_amdgcn_fence(__ATOMIC_ACQUIRE, "agent");
            asm volatile("s_waitcnt vmcnt(0)" ::: "memory");
        }
    }
    __syncthreads();
}

#define HD __device__ __forceinline__
#define SCHED_FENCE() __builtin_amdgcn_sched_barrier(0)
#define OPAQUE(x) asm volatile("" : "+v"(x))
#ifdef FFT_HOST
struct c32 { float x, y; };
#else
typedef float c32 __attribute__((ext_vector_type(2)));
#endif
HD c32 cmul(c32 a, c32 b) { c32 r; r.x = a.x * b.x - a.y * b.y; r.y = a.x * b.y + a.y * b.x; return r; }
HD c32 cmulc(c32 a, c32 b) { c32 r; r.x = a.x * b.x + a.y * b.y; r.y = a.y * b.x - a.x * b.y; return r; }
HD c32 cadd(c32 a, c32 b) { c32 r; r.x = a.x + b.x; r.y = a.y + b.y; return r; }
HD c32 csub(c32 a, c32 b) { c32 r; r.x = a.x - b.x; r.y = a.y - b.y; return r; }
HD c32 cconj(c32 a) { c32 r; r.x = a.x; r.y = -a.y; return r; }
HD int fpad(int e) { return e + ((e >> 6) << 2); }
#define FFT_L 16384
#define FFT_LDS_ELEMS (FFT_L + (FFT_L >> 6) * 4)
#ifdef FFT_HOST
struct f2p { float x, y; };
static inline f2p operator+(f2p a, f2p b) { return {a.x + b.x, a.y + b.y}; }
static inline f2p operator-(f2p a, f2p b) { return {a.x - b.x, a.y - b.y}; }
static inline f2p operator*(f2p a, f2p b) { return {a.x * b.x, a.y * b.y}; }
static inline f2p operator-(f2p a) { return {-a.x, -a.y}; }
static inline f2p f2splat(float v) { return {v, v}; }
#else
typedef float f2p __attribute__((ext_vector_type(2)));
HD f2p f2splat(float v) { return (f2p){v, v}; }
#endif
struct cxp { f2p x, y; };
HD cxp pmul(cxp a, cxp b) { cxp r; r.x = a.x * b.x - a.y * b.y; r.y = a.x * b.y + a.y * b.x; return r; }
HD cxp pmulc(cxp a, cxp b) { cxp r; r.x = a.x * b.x + a.y * b.y; r.y = a.y * b.x - a.x * b.y; return r; }
HD cxp padd(cxp a, cxp b) { cxp r; r.x = a.x + b.x; r.y = a.y + b.y; return r; }
HD cxp psub(cxp a, cxp b) { cxp r; r.x = a.x - b.x; r.y = a.y - b.y; return r; }
HD cxp pconst(float re, float im) { cxp r; r.x = f2splat(re); r.y = f2splat(im); return r; }
template <bool INV> HD void bfly4(cxp& a0, cxp& a1, cxp& a2, cxp& a3) {
    const cxp b0 = padd(a0, a2), b1 = psub(a0, a2), b2 = padd(a1, a3), b3 = psub(a1, a3);
    cxp ib3;
    if (!INV) { ib3.x = b3.y; ib3.y = -b3.x; } else { ib3.x = -b3.y; ib3.y = b3.x; }
    a0 = padd(b0, b2); a2 = psub(b0, b2); a1 = padd(b1, ib3); a3 = psub(b1, ib3);
}
HD cxp twid2(int j0, int j1, int n) { float s0, c0, s1, c1; sincospif(-2.0f * (float)j0 / (float)n, &s0, &c0); sincospif(-2.0f * (float)j1 / (float)n, &s1, &c1);
    cxp r; r.x.x = c0; r.x.y = c1; r.y.x = s0; r.y.y = s1; return r; }
HD void r16_fwd(cxp (&x)[16], cxp t1) {
    const float C8 = 0.92387953251128674f, S8 = 0.38268343236508977f, R2 = 0.70710678118654752f;
#pragma unroll
    for (int u = 0; u < 4; ++u) {
        bfly4<false>(x[u], x[u + 4], x[u + 8], x[u + 12]);
        const cxp wu = (u == 0) ? pconst(1.f, 0.f) : (u == 1) ? pconst(C8, -S8) : (u == 2) ? pconst(R2, -R2) : pconst(S8, -C8);
        const cxp a1 = (u == 0) ? t1 : pmul(t1, wu), a2 = pmul(a1, a1), a3 = pmul(a2, a1);
        x[u + 4] = pmul(x[u + 4], a1); x[u + 8] = pmul(x[u + 8], a2); x[u + 12] = pmul(x[u + 12], a3);
    }
    const cxp t2 = pmul(t1, t1), b1 = pmul(t2, t2), b2 = pmul(b1, b1), b3 = pmul(b2, b1);
#pragma unroll
    for (int p = 0; p < 4; ++p) {
        bfly4<false>(x[4 * p], x[4 * p + 1], x[4 * p + 2], x[4 * p + 3]);
        x[4 * p + 1] = pmul(x[4 * p + 1], b1); x[4 * p + 2] = pmul(x[4 * p + 2], b2); x[4 * p + 3] = pmul(x[4 * p + 3], b3);
    }
}
HD void r16_inv(cxp (&x)[16], cxp t1) {
    const float C8 = 0.92387953251128674f, S8 = 0.38268343236508977f, R2 = 0.70710678118654752f;
    const cxp t2 = pmul(t1, t1), b1 = pmul(t2, t2), b2 = pmul(b1, b1), b3 = pmul(b2, b1);
#pragma unroll
    for (int p = 0; p < 4; ++p) {
        x[4 * p + 1] = pmulc(x[4 * p + 1], b1); x[4 * p + 2] = pmulc(x[4 * p + 2], b2); x[4 * p + 3] = pmulc(x[4 * p + 3], b3);
        bfly4<true>(x[4 * p], x[4 * p + 1], x[4 * p + 2], x[4 * p + 3]);
    }
#pragma unroll
    for (int u = 0; u < 4; ++u) {
        const cxp wu = (u == 0) ? pconst(1.f, 0.f) : (u == 1) ? pconst(C8, -S8) : (u == 2) ? pconst(R2, -R2) : pconst(S8, -C8);
        const cxp a1 = (u == 0) ? t1 : pmul(t1, wu), a2 = pmul(a1, a1), a3 = pmul(a2, a1);
        x[u + 4] = pmulc(x[u + 4], a1); x[u + 8] = pmulc(x[u + 8], a2); x[u + 12] = pmulc(x[u + 12], a3);
        bfly4<true>(x[u], x[u + 4], x[u + 8], x[u + 12]);
    }
}
template <bool INV, int N, class P, class T, bool ZP = false, bool HO = false> HD void fft_pass16(P d, T tw, int tid) {
    OPAQUE(tid);
    constexpr int s = N >> 4, sp = (s >= 64) ? s + ((s >> 6) << 2) : s;
    const int b0 = tid, b1 = tid + 512;
    const int blk0 = b0 / s, j0 = b0 - blk0 * s, p0 = fpad(blk0 * N + j0), blk1 = b1 / s, j1 = b1 - blk1 * s, p1 = fpad(blk1 * N + j1);
    cxp x[16];
    { c32 ra[16], rb[16];
#pragma unroll
      for (int q = 0; q < 16; ++q) { if (ZP && q >= 8) { ra[q].x = 0.f; ra[q].y = 0.f; rb[q] = ra[q]; } else { ra[q] = d[p0 + q * sp]; rb[q] = d[p1 + q * sp]; } }
      SCHED_FENCE();
#pragma unroll
      for (int q = 0; q < 16; ++q) { x[q].x.x = ra[q].x; x[q].x.y = rb[q].x; x[q].y.x = ra[q].y; x[q].y.y = rb[q].y; } }
    cxp t1; { const c32 ta = tw[j0 * (FFT_L / N)], tb = tw[j1 * (FFT_L / N)]; t1.x.x = ta.x; t1.x.y = tb.x; t1.y.x = ta.y; t1.y.y = tb.y; }
    if (!INV) r16_fwd(x, t1); else r16_inv(x, t1);
#pragma unroll
    for (int q = 0; q < 16; ++q) { if (HO && q >= 8) continue; c32 a, b; a.x = x[q].x.x; a.y = x[q].y.x; b.x = x[q].x.y; b.y = x[q].y.y; d[p0 + q * sp] = a; d[p1 + q * sp] = b; }
}
template <bool INV, class P> HD void fft_pass4(P d, int tid) {
    OPAQUE(tid);
#pragma unroll 1
    for (int b = tid; b < FFT_L / 4; b += 1024) {
        const int ba = fpad(4 * b), bb = fpad(4 * (b + 512));
        cxp a[4];
#pragma unroll
        for (int q = 0; q < 4; ++q) { const c32 u = d[ba + q], v = d[bb + q]; a[q].x.x = u.x; a[q].x.y = v.x; a[q].y.x = u.y; a[q].y.y = v.y; }
        bfly4<INV>(a[0], a[1], a[2], a[3]);
#pragma unroll
        for (int q = 0; q < 4; ++q) { c32 u, v; u.x = a[q].x.x; u.y = a[q].y.x; v.x = a[q].x.y; v.y = a[q].y.y; d[ba + q] = u; d[bb + q] = v; }
    }
}
HD int rev4(int k) {
    unsigned x = (unsigned)k;
    x = ((x & 0x5555u) << 1) | ((x >> 1) & 0x5555u);
    x = ((x & 0x3333u) << 2) | ((x >> 2) & 0x3333u);
    x = ((x & 0x0f0fu) << 4) | ((x >> 4) & 0x0f0fu);
    x = ((x & 0x00ffu) << 8) | ((x >> 8) & 0x00ffu);
    x >>= 2;
    x = ((x & 0x1555u) << 1) | ((x >> 1) & 0x1555u);
    return (int)x;
}
HD void conv_pair(c32 C1, c32 C2, c32 K1, c32 K2, c32 w1, c32& D1, c32& D2) {
    c32 E1, O1;
    E1.x = 0.5f * (C1.x + C2.x); E1.y = 0.5f * (C1.y - C2.y);
    const float dx = 0.5f * (C1.x - C2.x), dy = 0.5f * (C1.y + C2.y);
    O1.x = dy; O1.y = -dx;
    const c32 wO = cmul(w1, O1);
    const c32 X1 = cadd(E1, wO), X2 = cconj(csub(E1, wO));
    const c32 Y1 = cmul(X1, K1), Y2 = cmul(X2, K2);
    c32 Ey, T;
    Ey.x = 0.5f * (Y1.x + Y2.x); Ey.y = 0.5f * (Y1.y - Y2.y);
    T.x = 0.5f * (Y1.x - Y2.x); T.y = 0.5f * (Y1.y + Y2.y);
    const c32 Oy = cmulc(T, w1);
    D1.x = Ey.x - Oy.y; D1.y = Ey.y + Oy.x;
    D2.x = Ey.x - Oy.y; D2.y = -Ey.y - Oy.x;
    D2.x = Ey.x + Oy.y; D2.y = Oy.x - Ey.y;
}
HD void spec_pair(c32 C1, c32 C2, c32 w1, c32& X1, c32& X2) {
    c32 E1, O1;
    E1.x = 0.5f * (C1.x + C2.x); E1.y = 0.5f * (C1.y - C2.y);
    const float dx = 0.5f * (C1.x - C2.x), dy = 0.5f * (C1.y + C2.y);
    O1.x = dy; O1.y = -dx;
    const c32 wO = cmul(w1, O1);
    X1 = cadd(E1, wO); X2 = cconj(csub(E1, wO));
}
struct Args { const float* in[34]; float* out; unsigned char* ws; };
enum { I_X = 0, I_C, I_CTX, I_CCTX, I_ADAW, I_ADAB, I_WIN, I_SINK, I_POOLW, I_POOLS, I_HYCW, I_HYCB, I_HYW1, I_HYB1, I_HYF1, I_HYW2, I_HYB2, I_HYF2, I_HYW3, I_HYBIAS,
       I_SCW, I_WBR, I_WOUT, I_LN1G, I_LN1B, I_LN2G, I_LN2B, I_RGW, I_RGB, I_REW, I_REB, I_EW1, I_EW3, I_EW2 };
struct Frame {
    LAS unsigned char* lds; volatile LAS unsigned* MISC;
    int tid, lane, wave, vcu, G, bid;
    const float* const* in; unsigned char* ws; float* out;
};
#define WSP(T, off) ((T*)(F.ws + (off)))

__device__ __forceinline__ void p0_mods(Frame& F) {
    LAS float* sl = (LAS float*)F.lds; LAS float* sc = sl + 1024; LAS float* red = sc + 1024;
    const float* c = F.in[I_C]; const float* cc = F.in[I_CCTX];
    for (int i = F.tid; i < 1024; i += 512) { const float a = c[i], b = cc[i]; sl[i] = a / (1.f + expf(-a)); sc[i] = b / (1.f + expf(-b)); }
    __syncthreads();
    float* MOD = WSP(float, WS_MOD);
    for (int item = F.bid; item < 256; item += F.G) {
        const int g = F.tid % 24, ks = F.tid / 24;
        const int col = (item * 24 + g) * 4, layer = col / 6144, n = col % 6144;
        if (ks < 16) {
            const float* W = F.in[I_ADAW] + (size_t)layer * 1024 * 6144 + n;
            f32x4 al = {0.f, 0.f, 0.f, 0.f}, ac = {0.f, 0.f, 0.f, 0.f};
#pragma unroll 8
            for (int k = ks * 64; k < ks * 64 + 64; ++k) { const f32x4 w = *(const GAS f32x4*)(W + (size_t)k * 6144); al += w * sl[k]; ac += w * sc[k]; }
            LAS float* r = red + (ks * 24 + g) * 8;
            r[0] = al.x; r[1] = al.y; r[2] = al.z; r[3] = al.w; r[4] = ac.x; r[5] = ac.y; r[6] = ac.z; r[7] = ac.w;
        }
        __syncthreads();
        if (F.tid < 192) {
            const int g2 = F.tid >> 3, e = F.tid & 7; float s = 0.f;
            for (int k2 = 0; k2 < 16; ++k2) s += red[(k2 * 24 + g2) * 8 + e];
            const int col2 = (item * 24 + g2) * 4, layer2 = col2 / 6144, n2 = col2 % 6144 + (e & 3);
            s += F.in[I_ADAB][layer2 * 6144 + n2];
            MOD[(layer2 * 2 + (e >> 2)) * 6144 + n2] = s;
        }
        __syncthreads();
    }
}
__device__ __forceinline__ void p0_tables(Frame& F) {
    const int gt = F.bid * 512 + F.tid, NT = F.G * 512;
    float* rc = WSP(float, WS_ROPE); float* rs = rc + 320 * 16;
    for (int i = gt; i < 320 * 16; i += NT) {
        const int p = i >> 4, j = i & 15; const float pos = (float)(p < 256 ? p : p - 256);
        const float inv = exp2f(-(float)j * (13.287712379549449f / 16.0f)); const float ang = pos * inv;
        rc[i] = cosf(ang); rs[i] = sinf(ang);
    }
    bf16* W3T = WSP(bf16, WS_W3T);
#pragma unroll 4
    for (int i = gt; i < NLAYER * 64 * 2048; i += NT) {
        const int col = i & 2047, k = (i >> 11) & 63, layer = i >> 17;
        W3T[((size_t)layer * 2048 + col) * 128 + k] = (bf16)f2bf(F.in[I_HYW3][((size_t)layer * 64 + k) * 2048 + col]);
    }
    for (int i = gt; i < NLAYER * 2048 * 32; i += NT) {
        const int q = i & 31, row = i >> 5;
        ((unsigned*)W3T)[(size_t)row * 64 + 32 + q] = 0u;
    }
    const int gw = F.bid * NWAVES + F.wave, NGW = F.G * NWAVES;
    bf16* H2B = WSP(bf16, WS_HDN2B); float* H2C = WSP(float, WS_HDN2C);
    for (int it = gw; it < NLAYER * (ML + MC); it += NGW) {
        const int layer = it / (ML + MC), tt = it % (ML + MC); const bool isc = tt >= ML; const int t = isc ? tt - ML : tt, l = isc ? MC : ML;
        const int j = F.lane;
        float feat = 0.f;
        if (j == 0) feat = (float)t / (float)(l - 1);
        else if (j <= 32) { const int b = (j - 1) & 15; const float fr = 1e-4f + (float)b * ((15.0f - 1e-4f) / 15.0f);
            float u = (float)t * fr / (float)l; u -= rintf(u); float s, c; sincospif(2.f * u, &s, &c); feat = (j <= 16) ? c : -s; }
        const float* w1 = F.in[I_HYW1] + (size_t)layer * 33 * 64; const float* w2 = F.in[I_HYW2] + (size_t)layer * 64 * 64;
        float h = F.in[I_HYB1][layer * 64 + j];
#pragma unroll
        for (int i = 0; i < 33; ++i) h += __shfl(feat, i) * w1[i * 64 + j];
        h = __sinf(F.in[I_HYF1][layer * 64 + j] * h);
        float h2 = F.in[I_HYB2][layer * 64 + j];
#pragma unroll 16
        for (int i = 0; i < 64; ++i) h2 += __shfl(h, i) * w2[i * 64 + j];
        h2 = __sinf(F.in[I_HYF2][layer * 64 + j] * h2);
        if (isc) H2C[((size_t)layer * MC + t) * 64 + j] = h2;
        else { bf16* o = H2B + ((size_t)layer * ML + t) * 128; o[j] = (bf16)f2bf(h2); o[64 + j] = 0; }
    }
}

struct CvtJob { const float* W; bf16* WT; int K, N, mode, rs, roff, k0, n0; };
__device__ __forceinline__ void cvt_load(const CvtJob& J, int lane, f32x4 (&v)[16]) {
    const int kr = lane >> 4, nq = (lane & 15) << 2;
#pragma unroll
    for (int i = 0; i < 16; ++i) v[i] = __builtin_nontemporal_load((const GAS f32x4*)(J.W + (size_t)(J.k0 + 4 * i + kr) * J.N + J.n0 + nq));
}
__device__ __forceinline__ void cvt_store(const CvtJob& J, int lane, const f32x4 (&v)[16], LAS float* scr) {
    const int kr = lane >> 4, nq = (lane & 15) << 2;
#pragma unroll
    for (int i = 0; i < 16; ++i) { LAS float* p = scr + nq * 65 + 4 * i + kr; p[0] = v[i].x; p[65] = v[i].y; p[130] = v[i].z; p[195] = v[i].w; }
    LDS_WAIT(); asm volatile("" ::: "memory");
    const int c = lane & 7;
#pragma unroll
    for (int jj = 0; jj < 8; ++jj) {
        const int nl = (lane >> 3) + 8 * jj, n = J.n0 + nl; int dest;
        if (J.mode == 1) { if (n < 640) { const int d = n & 63; dest = (n & ~63) | (d & 32) | ((d & 15) << 1) | ((d >> 4) & 1); } else dest = n; }
        else dest = J.roff + J.rs * n;
        const LAS float* sp = scr + nl * 65 + 8 * c;
        u32x4 o; o.x = pk2(sp[0], sp[1]); o.y = pk2(sp[2], sp[3]); o.z = pk2(sp[4], sp[5]); o.w = pk2(sp[6], sp[7]);
        *(GAS u32x4*)(J.WT + (size_t)dest * J.K + J.k0 + 8 * c) = o;
    }
    LDS_WAIT(); asm volatile("" ::: "memory");
}
__device__ __forceinline__ CvtJob cvt_decode(Frame& F, int layer, int it) {
    constexpr int I_IN = 4 * 66, I_BR = 2 * 8, I_OUT = 4 * 8, I_E13 = 4 * 4, I_E2 = 2 * 8;
    constexpr int N1 = I_IN, N2 = N1 + 3 * I_BR, N3 = N2 + I_OUT, N4 = N3 + 32 * I_E13, N5 = N4 + 32 * I_E13;
    CvtJob J; int r, nbw;
    if (it < N1) { J.W = F.in[I_WIN] + (size_t)layer * 1024 * INCOLS; J.K = 1024; J.N = INCOLS; J.WT = WSP(bf16, WS_WIN); J.mode = 1; J.rs = 1; J.roff = 0; r = it; nbw = 66; }
    else if (it < N2) { const int q = it - N1, b = q / I_BR, nb = b == 0 ? 0 : b + 1; J.W = F.in[I_WBR] + ((size_t)layer * 4 + nb) * 512 * 1024; J.K = 512; J.N = 1024; J.WT = WSP(bf16, WS_WBR); J.mode = 0; J.rs = 1; J.roff = nb * 1024; r = q - b * I_BR; nbw = 8; }
    else if (it < N3) { J.W = F.in[I_WOUT] + (size_t)layer * 1024 * 1024; J.K = 1024; J.N = 1024; J.WT = WSP(bf16, WS_WOUT); J.mode = 0; J.rs = 1; J.roff = 0; r = it - N2; nbw = 8; }
    else if (it < N4) { const int q = it - N3, e = q / I_E13; J.W = F.in[I_EW1] + ((size_t)layer * 32 + e) * 1024 * 512; J.K = 1024; J.N = 512; J.WT = WSP(bf16, WS_W13); J.mode = 0; J.rs = 2; J.roff = e * 1024; r = q - e * I_E13; nbw = 4; }
    else if (it < N5) { const int q = it - N4, e = q / I_E13; J.W = F.in[I_EW3] + ((size_t)layer * 32 + e) * 1024 * 512; J.K = 1024; J.N = 512; J.WT = WSP(bf16, WS_W13); J.mode = 0; J.rs = 2; J.roff = e * 1024 + 1; r = q - e * I_E13; nbw = 4; }
    else { const int q = it - N5, e = q / I_E2; J.W = F.in[I_EW2] + ((size_t)layer * 32 + e) * 512 * 1024; J.K = 512; J.N = 1024; J.WT = WSP(bf16, WS_W2); J.mode = 0; J.rs = 1; J.roff = e * 1024; r = q - e * I_E2; nbw = 8; }
    if (it >= N3) {
        const int sbw = J.N >> 9, kb = r / sbw, sb = r - kb * sbw;
        J.k0 = kb * 64; J.n0 = sb * 512 + F.wave * 64;
    } else {
    const int kb0 = r / nbw, nb0 = r - kb0 * nbw;
    J.k0 = kb0 * 256 + (F.wave & 3) * 64; J.n0 = nb0 * 128 + (F.wave >> 2) * 64;
    }
    return J;
}
__device__ __forceinline__ void p1_convert(Frame& F, int layer) {
    LAS float* scr = (LAS float*)(F.lds + F.wave * 17408);
    const int gw = F.vcu * NWAVES + F.wave, NGW = F.G * NWAVES;
    constexpr int NITEMS = 4 * 66 + 3 * 16 + 32 + 32 * 16 * 2 + 32 * 16;
    {
        int it = F.vcu;
        f32x4 va[16], vb[16];
        if (it < NITEMS) { CvtJob J = cvt_decode(F, layer, it); cvt_load(J, F.lane, va); }
#pragma unroll 1
        for (; it < NITEMS; it += 2 * F.G) {
            const CvtJob J0 = cvt_decode(F, layer, it);
            const bool h1 = (it + F.G) < NITEMS;
            CvtJob J1 = J0; if (h1) { J1 = cvt_decode(F, layer, it + F.G); cvt_load(J1, F.lane, vb); }
            cvt_store(J0, F.lane, va, scr);
            if (h1) { if (it + 2 * F.G < NITEMS) { const CvtJob J2 = cvt_decode(F, layer, it + 2 * F.G); cvt_load(J2, F.lane, va); } cvt_store(J1, F.lane, vb, scr); }
        }
    }
    const float* pw = F.in[I_POOLW] + (size_t)layer * 4 * 128 * 128; const float* ps = F.in[I_POOLS] + (size_t)layer * 512; const float* wb = F.in[I_WBR] + ((size_t)layer * 4 + 1) * 512 * 1024;
    bf16* WBRT = WSP(bf16, WS_WBR);
    for (int it = gw; it < 512 * 4; it += NGW) {
        const int gc = it >> 2, d0 = (it & 3) * 256 + 4 * F.lane, g = gc >> 7;
        f32x4 a = {0.f, 0.f, 0.f, 0.f};
#pragma unroll 32
        for (int e = 0; e < 128; ++e) { const float coef = pw[(size_t)gc * 128 + e] * ps[g * 128 + e]; a += *(const GAS f32x4*)(wb + (size_t)(g * 128 + e) * 1024 + d0) * coef; }
#pragma unroll
        for (int i = 0; i < 4; ++i) WBRT[(size_t)(1024 + d0 + i) * 512 + gc] = (bf16)f2bf(a[i]);
    }
}

__device__ __forceinline__ void row_load(const float* p, int lane, f32x4 (&v)[4]) {
#pragma unroll
    for (int j = 0; j < 4; ++j) v[j] = *(const GAS f32x4*)(p + 4 * lane + 256 * j);
}
__device__ __forceinline__ void row_load_bf16(const bf16* p, int lane, f32x4 (&v)[4]) {
#pragma unroll
    for (int j = 0; j < 4; ++j) { const u32x2 w = *(const GAS u32x2*)(p + 4 * lane + 256 * j); v[j].x = bflo(w.x); v[j].y = bfhi(w.x); v[j].z = bflo(w.y); v[j].w = bfhi(w.y); }
}
__device__ __forceinline__ void row_norm(f32x4 (&v)[4]) {
    float s = 0.f;
#pragma unroll
    for (int j = 0; j < 4; ++j) s += (v[j].x + v[j].y) + (v[j].z + v[j].w);
    const float mean = wave_sum(s) * (1.f / 1024.f); float q = 0.f;
#pragma unroll
    for (int j = 0; j < 4; ++j) { v[j] = v[j] - mean; q += (v[j].x * v[j].x + v[j].y * v[j].y) + (v[j].z * v[j].z + v[j].w * v[j].w); }
    const float rstd = rsqrtf(wave_sum(q) * (1.f / 1024.f) + LN_EPS);
#pragma unroll
    for (int j = 0; j < 4; ++j) v[j] = v[j] * rstd;
}
__device__ __forceinline__ void row_store_bf16(bf16* p, int lane, const f32x4 (&v)[4]) {
#pragma unroll
    for (int j = 0; j < 4; ++j) { u32x2 w; w.x = pk2(v[j].x, v[j].y); w.y = pk2(v[j].z, v[j].w); *(GAS u32x2*)(p + 4 * lane + 256 * j) = w; }
}
__device__ __forceinline__ void p_xn0(Frame& F) {
    const int gw = F.vcu * NWAVES + F.wave, NGW = F.G * NWAVES;
    const float* MOD = WSP(float, WS_MOD); bf16* XN = WSP(bf16, WS_XN);
    for (int r = gw; r < MT; r += NGW) {
        const bool isc = r >= ML; const float* xr = isc ? F.in[I_CTX] + (size_t)(r - ML) * 1024 : F.in[I_X] + (size_t)r * 1024;
        const float* md = MOD + (isc ? 6144 : 0);
        f32x4 v[4]; row_load(xr, F.lane, v); row_norm(v);
#pragma unroll
        for (int j = 0; j < 4; ++j) { const f32x4 sh = *(const GAS f32x4*)(md + 4 * F.lane + 256 * j), sc = *(const GAS f32x4*)(md + 1024 + 4 * F.lane + 256 * j); v[j] = v[j] * (sc + 1.f) + sh; }
        row_store_bf16(XN + (size_t)r * 1024, F.lane, v);
    }
}
__device__ __forceinline__ float block_sum(Frame& F, float v) {
    v = wave_sum(v);
    __syncthreads();
    if (F.lane == 0) ((volatile LAS float*)F.MISC)[32 + F.wave] = v;
    __syncthreads();
    float s = 0.f;
#pragma unroll
    for (int w = 0; w < NWAVES; ++w) s += ((volatile LAS float*)F.MISC)[32 + w];
    return s;
}
#define FTW_LDS(d) ((const LAS c32*)((LAS unsigned char*)(d) + 139264))
template <bool PRUNE = false> __device__ __forceinline__ void fft_forward(LAS c32* d, int tid) {
    const LAS c32* tw = FTW_LDS(d);
    fft_pass16<false, 16384, LAS c32*, const LAS c32*, PRUNE, false>(d, tw, tid); __syncthreads(); fft_pass16<false, 1024>(d, tw, tid); __syncthreads(); fft_pass16<false, 64>(d, tw, tid); __syncthreads(); fft_pass4<false>(d, tid); __syncthreads();
}
template <bool PRUNE = false> __device__ __forceinline__ void fft_inverse(LAS c32* d, int tid) {
    const LAS c32* tw = FTW_LDS(d);
    fft_pass4<true>(d, tid); __syncthreads(); fft_pass16<true, 64>(d, tw, tid); __syncthreads(); fft_pass16<true, 1024>(d, tw, tid); __syncthreads(); fft_pass16<true, 16384, LAS c32*, const LAS c32*, false, PRUNE>(d, tw, tid); __syncthreads();
}
#define PTW_LDS(F) ((volatile LAS c32*)((F).MISC + 64))
__device__ __forceinline__ void ptw_init(Frame& F) {
    { LAS c32* ftw = (LAS c32*)(F.lds + 139264);
#pragma unroll
      for (int q = 0; q < 2; ++q) { const int j = F.tid + 512 * q; float sn, cs; sincospif(-2.0f * (float)j * (1.0f / (float)FFT_L), &sn, &cs); c32 w; w.x = cs; w.y = sn; ftw[j] = w; } }
    if (F.tid < 32) { const int rc = rev4(512 * F.tid); float sn, cs; sincospif(-(float)rc * (1.0f / (float)FFT_L), &sn, &cs); c32 w; w.x = cs; w.y = sn; PTW_LDS(F)[F.tid] = w; }
    __syncthreads();
}
__device__ __forceinline__ float hy_delta(int c) { const float a = -4.605170185988091f / 1.5f, b = -4.605170185988091f / 0.3f; return fabsf(a + (float)c * ((b - a) / 511.0f)); }
__device__ __forceinline__ void filter_unit(Frame& F, int unit) {
    LAS c32* d = (LAS c32*)F.lds;
    const int o = unit >> 9, c = unit & 511;
    const bf16* tf = WSP(bf16, WS_TAPS) + (size_t)((2 * o) * 512 + c) * ML; const bf16* tb = WSP(bf16, WS_TAPS) + (size_t)((2 * o + 1) * 512 + c) * ML;
    const float dl2 = hy_delta(c) * LOG2E * (1.0f / (float)(ML - 1));
    float ss = 0.f;
    int tid = F.tid; OPAQUE(tid);
#pragma unroll 1
    for (int b = 0; b < 2; ++b) {
        unsigned raw[8];
#pragma unroll
        for (int i = 0; i < 8; ++i) raw[i] = *(const GAS unsigned*)(tf + 2 * (tid + 512 * (8 * b + i)));
#pragma unroll
        for (int i = 0; i < 8; ++i) { const int m = tid + 512 * (8 * b + i);
            const float k0 = bflo(raw[i]) * (__builtin_amdgcn_exp2f(-dl2 * (float)(2 * m)) + 0.05f), k1 = bfhi(raw[i]) * (__builtin_amdgcn_exp2f(-dl2 * (float)(2 * m + 1)) + 0.05f);
            ss += k0 * k0 + k1 * k1; c32 v; v.x = k0; v.y = k1; d[fpad(m)] = v; }
    }
#pragma unroll 1
    for (int b = 2; b < 4; ++b) {
        unsigned short ra[8], rb[8];
#pragma unroll
        for (int i = 0; i < 8; ++i) { const int m = tid + 512 * (8 * b + i), j0 = 2 * ML - 2 * m; ra[i] = (j0 < ML) ? tb[j0] : (unsigned short)0; rb[i] = tb[j0 - 1]; }
#pragma unroll
        for (int i = 0; i < 8; ++i) { const int m = tid + 512 * (8 * b + i), j0 = 2 * ML - 2 * m;
            const float k0 = (j0 < ML) ? bf2f(ra[i]) * (__builtin_amdgcn_exp2f(-dl2 * (float)j0) + 0.05f) : 0.f, k1 = bf2f(rb[i]) * (__builtin_amdgcn_exp2f(-dl2 * (float)(j0 - 1)) + 0.05f);
            ss += k0 * k0 + k1 * k1; c32 v; v.x = k0; v.y = k1; d[fpad(m)] = v; }
    }
    unsigned pf0 = 0, pf1 = 0;
    { const int nu = unit + F.G;
      if (nu < 1024) { const int no = nu >> 9, nc = nu & 511;
        const bf16* nb = WSP(bf16, WS_TAPS) + (size_t)((2 * no + (tid >> 8)) * 512 + nc) * ML + (tid & 255) * 64;
        pf0 = *(volatile const GAS unsigned*)nb; pf1 = *(volatile const GAS unsigned*)(nb + 32); } }
    const float tot = block_sum(F, ss);
    const float scale = rsqrtf(tot + LN_EPS) * (1.0f / (float)FFT_L);
    fft_forward(d, tid);
    unsigned* KS = WSP(unsigned, WS_KSPEC) + (size_t)unit * FFT_L;
    OPAQUE(tid);
    const int K0 = rev4(tid); c32 W0; { float sn, cs; sincospif(-(float)K0 * (1.0f / (float)FFT_L), &sn, &cs); W0.x = cs; W0.y = sn; }
    volatile LAS c32* ptw = PTW_LDS(F);
#pragma unroll 4
    for (int i = 0; i < 32; ++i) {
        const int P = tid + 512 * i;
        const int k = rev4(P), P2 = rev4((FFT_L - k) & (FFT_L - 1));
        const c32 w1 = cmul(W0, ptw[i]);
        c32 X1, X2; spec_pair(d[fpad(P)], d[fpad(P2)], w1, X1, X2);
        c32 r; r.x = X1.x * scale; r.y = (k == 0 ? X2.x : X1.y) * scale;
        *(GAS unsigned*)(KS + P) = pk2(r.x, r.y);
    }
    asm volatile("" :: "v"(pf0), "v"(pf1));
    __syncthreads();
}

__device__ __forceinline__ void conv_pairs(Frame& F, LAS c32* d, const unsigned* KS, int tid) {
    OPAQUE(tid);
    const int K0 = rev4(tid); c32 W0; { float sn, cs; sincospif(-(float)K0 * (1.0f / (float)FFT_L), &sn, &cs); W0.x = cs; W0.y = sn; }
    volatile LAS c32* ptw = PTW_LDS(F);
#pragma unroll 1
    for (int b = 0; b < 4; ++b) {
        int P2[8]; c32 K1[8], K2[8];
#pragma unroll
        for (int i = 0; i < 8; ++i) { const int P = tid + 512 * (8 * b + i), k = rev4(P); P2[i] = rev4((FFT_L - k) & (FFT_L - 1));
            K1[i] = (c32){0.f, 0.f}; K2[i] = (c32){0.f, 0.f};
            if (P <= P2[i]) { const unsigned u1 = *(const GAS unsigned*)(KS + P), u2 = *(const GAS unsigned*)(KS + P2[i]); K1[i].x = bflo(u1); K1[i].y = bfhi(u1); K2[i].x = bflo(u2); K2[i].y = bfhi(u2); } }
#pragma unroll
        for (int i = 0; i < 8; ++i) { const int P = tid + 512 * (8 * b + i);
            if (P <= P2[i]) {
                const int k = rev4(P);
                const c32 w1 = cmul(W0, ptw[8 * b + i]);
                c32 k1 = K1[i], k2 = K2[i];
                if (k == 0) { k2.x = k1.y; k2.y = 0.f; k1.y = 0.f; }
                c32 D1, D2; conv_pair(d[fpad(P)], d[fpad(P2[i])], k1, k2, w1, D1, D2);
                d[fpad(P)] = D1; if (P2[i] != P) d[fpad(P2[i])] = D2;
            } }
    }
}
#define WARM(base, stride) (*(volatile const GAS unsigned*)((const char*)(base) + tid * (stride)))
__device__ __forceinline__ void hyena_channel(Frame& F, int layer, int c, int cn, unsigned (&outp)[16]) {
    LAS c32* d = (LAS c32*)F.lds;
    const bf16* HT = WSP(bf16, WS_HT);
    const bf16* x1p = HT + (size_t)c * ML; const bf16* x2p = HT + (size_t)(512 + c) * ML; const bf16* vp = HT + (size_t)(1024 + c) * ML;
    const unsigned* KS0 = WSP(unsigned, WS_KSPEC) + (size_t)c * FFT_L; const unsigned* KS1 = WSP(unsigned, WS_KSPEC) + (size_t)(512 + c) * FFT_L;
    const float b0 = F.in[I_HYBIAS][(layer * 2 + 0) * 512 + c], b1 = F.in[I_HYBIAS][(layer * 2 + 1) * 512 + c];
    int tid = F.tid; OPAQUE(tid);
#pragma unroll
    for (int i = 0; i < 16; ++i) { const int m = tid + 512 * i; c32 v; const unsigned w = *(const GAS unsigned*)(vp + 2 * m); v.x = bflo(w); v.y = bfhi(w); d[fpad(m)] = v; }
    const unsigned w0 = WARM(KS0, 128);
    __syncthreads();
    fft_forward<true>(d, tid); asm volatile("" :: "v"(w0)); conv_pairs(F, d, KS0, tid); __syncthreads(); fft_inverse<true>(d, tid);
    c32 z1[16];
    OPAQUE(tid);
#pragma unroll
    for (int i = 0; i < 16; ++i) { const int m = tid + 512 * i; const c32 y = d[fpad(m)];
        const unsigned wv = *(const GAS unsigned*)(vp + 2 * m), wx = *(const GAS unsigned*)(x1p + 2 * m);
        z1[i].x = bflo(wx) * (y.x + b0 * bflo(wv)); z1[i].y = bfhi(wx) * (y.y + b0 * bfhi(wv)); }
    __syncthreads();
    OPAQUE(tid);
#pragma unroll
    for (int i = 0; i < 16; ++i) { const int m = tid + 512 * i; d[fpad(m)] = z1[i]; }
    const unsigned w2 = WARM(KS1, 128), w4 = (cn >= 0) ? WARM(HT + (size_t)(1024 + cn) * ML, 64) : 0u;
    __syncthreads();
    fft_forward<true>(d, tid); asm volatile("" :: "v"(w2), "v"(w4)); conv_pairs(F, d, KS1, tid); __syncthreads(); fft_inverse<true>(d, tid);
    OPAQUE(tid);
#pragma unroll
    for (int i = 0; i < 16; ++i) { const int m = tid + 512 * i; const c32 y = d[fpad(m)];
        const unsigned wx = *(const GAS unsigned*)(x2p + 2 * m);
        outp[i] = pk2(bflo(wx) * (y.x + b1 * z1[i].x), bfhi(wx) * (y.y + b1 * z1[i].y)); }
    __syncthreads();
}
__device__ __forceinline__ void hyena_unit(Frame& F, int layer, int u) {
    unsigned o0[16], o1[16];
    hyena_channel(F, layer, 2 * u, 2 * u + 1, o0);
    hyena_channel(F, layer, 2 * u + 1, -1, o1);
    bf16* dst = WSP(bf16, WS_ABR) + (size_t)2 * MT * 512 + 2 * u;
    int tid = F.tid; OPAQUE(tid);
#pragma unroll
    for (int i = 0; i < 16; ++i) { const int m = tid + 512 * i;
        *(GAS unsigned*)(dst + (size_t)(2 * m) * 512) = (o0[i] & 0xffffu) | (o1[i] << 16);
        *(GAS unsigned*)(dst + (size_t)(2 * m + 1) * 512) = (o0[i] >> 16) | (o1[i] & 0xffff0000u); }
}
__device__ __forceinline__ void hyena_ctx_unit(Frame& F, int layer, int unit) {
    LAS float* S = (LAS float*)F.lds;
    const int ch = F.tid >> 8, t = F.tid & 255, c = unit * 2 + ch;
    LAS float* w3s = S + ch * 256;
    LAS float* tap = S + 512 + ch * 1024;
    LAS float* zz = S + 2560 + ch * 256;
    LAS float* red = S + 3072;
    const float* w3 = F.in[I_HYW3] + (size_t)layer * 64 * 2048;
    { const int q = t >> 6, j = t & 63; w3s[q * 64 + j] = w3[(size_t)j * 2048 + q * 512 + c]; }
    __syncthreads();
    const float* h2 = WSP(float, WS_HDN2C) + ((size_t)layer * MC + t) * 64;
    float a[4] = {0.f, 0.f, 0.f, 0.f};
#pragma unroll 4
    for (int j4 = 0; j4 < 16; ++j4) { const f32x4 h = *(const GAS f32x4*)(h2 + 4 * j4);
#pragma unroll
        for (int q = 0; q < 4; ++q) a[q] += h.x * w3s[q * 64 + 4 * j4] + h.y * w3s[q * 64 + 4 * j4 + 1] + h.z * w3s[q * 64 + 4 * j4 + 2] + h.w * w3s[q * 64 + 4 * j4 + 3]; }
    const float win = __expf(-((float)t / 255.0f) * hy_delta(c)) + 0.05f;
    float ssq[2];
#pragma unroll
    for (int o = 0; o < 2; ++o) { const float f = a[2 * o] * win, b = a[2 * o + 1] * win; tap[(2 * o) * 256 + t] = f; tap[(2 * o + 1) * 256 + t] = b; ssq[o] = f * f + (t > 0 ? b * b : 0.f); }
    const bf16* HTC = WSP(bf16, WS_HTC);
    const float x1 = bf2f(HTC[(size_t)c * MC + t]), x2 = bf2f(HTC[(size_t)(512 + c) * MC + t]), v = bf2f(HTC[(size_t)(1024 + c) * MC + t]);
    zz[t] = v;
    const float s0 = wave_sum(ssq[0]), s1 = wave_sum(ssq[1]);
    if (F.lane == 0) { red[(ch * 2 + 0) * 4 + (F.wave & 3)] = s0; red[(ch * 2 + 1) * 4 + (F.wave & 3)] = s1; }
    __syncthreads();
    const float sc0 = rsqrtf(red[(ch * 2) * 4] + red[(ch * 2) * 4 + 1] + red[(ch * 2) * 4 + 2] + red[(ch * 2) * 4 + 3] + LN_EPS);
    const float sc1 = rsqrtf(red[(ch * 2 + 1) * 4] + red[(ch * 2 + 1) * 4 + 1] + red[(ch * 2 + 1) * 4 + 2] + red[(ch * 2 + 1) * 4 + 3] + LN_EPS);
    float y = 0.f;
#pragma unroll 16
    for (int s = 0; s < 256; ++s) { const int dlt = t - s; const float kk = tap[dlt >= 0 ? dlt : 256 - dlt]; y += kk * zz[s]; }
    const float z1 = x1 * (sc0 * y + F.in[I_HYBIAS][(layer * 2 + 0) * 512 + c] * v);
    __syncthreads();
    zz[t] = z1;
    __syncthreads();
    y = 0.f;
#pragma unroll 16
    for (int s = 0; s < 256; ++s) { const int dlt = t - s; const float kk = tap[dlt >= 0 ? 512 + dlt : 768 - dlt]; y += kk * zz[s]; }
    const float outv = x2 * (sc1 * y + F.in[I_HYBIAS][(layer * 2 + 1) * 512 + c] * z1);
    WSP(bf16, WS_ABR)[((size_t)2 * MT + ML + t) * 512 + c] = (bf16)f2bf(outv);
    __syncthreads();
}
template <int W> __device__ __forceinline__ void pool_strip(const bf16* U, bf16* O, int ts, int slen, int p) {
    constexpr int left = W / 2, right = W / 2 - 1, NR = 32 + W - 1;
    unsigned raw[NR];
#pragma unroll
    for (int j = 0; j < NR; ++j) { const int t = ts - left + j; raw[j] = (t >= 0 && t < slen) ? *(const GAS unsigned*)(U + (size_t)t * 512 + 2 * p) : 0u; }
    float S0 = 0.f, S1 = 0.f;
#pragma unroll
    for (int j = 0; j < W; ++j) { S0 += bflo(raw[j]); S1 += bfhi(raw[j]); }
#pragma unroll
    for (int i = 0; i < 32; ++i) {
        const int t = ts + i, lo = max(t - left, 0), hi = min(t + right + 1, slen);
        const float inv = __builtin_amdgcn_rcpf((float)(hi - lo));
        *(GAS unsigned*)(O + (size_t)t * 512 + 2 * p) = pk2(S0 * inv - bflo(raw[i + left]), S1 * inv - bfhi(raw[i + left]));
        if (i < 31) { S0 += bflo(raw[i + W]) - bflo(raw[i]); S1 += bfhi(raw[i + W]) - bfhi(raw[i]); }
    }
}
__device__ __forceinline__ void token_block_item(Frame& F, int layer, int seq0, int slen, int t0, bf16* hT, int hT_ld) {
    const int p = F.tid & 255, ts = t0 + 32 * (F.tid >> 8);
    {
        const bf16* U = WSP(bf16, WS_POOL) + (size_t)seq0 * 512; bf16* O = WSP(bf16, WS_ABR) + ((size_t)1 * MT + seq0) * 512;
        const int g = __builtin_amdgcn_readfirstlane(p >> 6);
        if (g == 0) pool_strip<2>(U, O, ts, slen, p); else if (g == 1) pool_strip<4>(U, O, ts, slen, p); else if (g == 2) pool_strip<8>(U, O, ts, slen, p); else pool_strip<16>(U, O, ts, slen, p);
    }
    {
        const bf16* U = WSP(bf16, WS_SC) + (size_t)seq0 * 1536 + 2 * p; bf16* O = WSP(bf16, WS_ABR) + ((size_t)3 * MT + seq0) * 512 + 2 * p;
        const float* cw = F.in[I_SCW] + (size_t)layer * 3 * 512 + 2 * p;
        const f32x2 w0 = *(const GAS f32x2*)cw, w1 = *(const GAS f32x2*)(cw + 512), w2 = *(const GAS f32x2*)(cw + 1024);
        unsigned rc[34], rx[34], rb[32];
#pragma unroll
        for (int j = 0; j < 34; ++j) { const int t = ts - 1 + j; const bool ok = (t >= 0 && t < slen);
            rc[j] = ok ? *(const GAS unsigned*)(U + (size_t)t * 1536 + 512) : 0u; rx[j] = ok ? *(const GAS unsigned*)(U + (size_t)t * 1536 + 1024) : 0u; }
#pragma unroll
        for (int i = 0; i < 32; ++i) rb[i] = *(const GAS unsigned*)(U + (size_t)(ts + i) * 1536);
        float pa0 = bflo(rc[0]) * bflo(rx[0]), pa1 = bfhi(rc[0]) * bfhi(rx[0]), pb0 = bflo(rc[1]) * bflo(rx[1]), pb1 = bfhi(rc[1]) * bfhi(rx[1]);
#pragma unroll
        for (int i = 0; i < 32; ++i) {
            const float pc0 = bflo(rc[i + 2]) * bflo(rx[i + 2]), pc1 = bfhi(rc[i + 2]) * bfhi(rx[i + 2]);
            *(GAS unsigned*)(O + (size_t)(ts + i) * 512) = pk2(bflo(rb[i]) * (w0.x * pa0 + w1.x * pb0 + w2.x * pc0), bfhi(rb[i]) * (w0.y * pa1 + w1.y * pb1 + w2.y * pc1));
            pa0 = pb0; pa1 = pb1; pb0 = pc0; pb1 = pc1;
        }
    }
#pragma unroll 1
    for (int q = 0; q < 3; ++q) {
        const int task = F.tid + 512 * q, pr = task % 768, tsh = t0 + 32 * (task / 768);
        const bf16* U = WSP(bf16, WS_HY) + (size_t)seq0 * 1536 + 2 * pr;
        const float* cw = F.in[I_HYCW] + (size_t)layer * 3 * 1536 + 2 * pr;
        const f32x2 w0 = *(const GAS f32x2*)cw, w1 = *(const GAS f32x2*)(cw + 1536), w2 = *(const GAS f32x2*)(cw + 3072), bb = *(const GAS f32x2*)(F.in[I_HYCB] + layer * 1536 + 2 * pr);
        unsigned ru[34];
#pragma unroll
        for (int j = 0; j < 34; ++j) { const int t = tsh - 1 + j; ru[j] = (t >= 0 && t < slen) ? *(const GAS unsigned*)(U + (size_t)t * 1536) : 0u; }
#pragma unroll
        for (int g8 = 0; g8 < 4; ++g8) {
            float r0[8], r1[8];
#pragma unroll
            for (int i = 0; i < 8; ++i) { const int j = 8 * g8 + i;
                r0[i] = w0.x * bflo(ru[j]) + w1.x * bflo(ru[j + 1]) + w2.x * bflo(ru[j + 2]) + bb.x; r1[i] = w0.y * bfhi(ru[j]) + w1.y * bfhi(ru[j + 1]) + w2.y * bfhi(ru[j + 2]) + bb.y; }
            u32x4 o0, o1; o0.x = pk2(r0[0], r0[1]); o0.y = pk2(r0[2], r0[3]); o0.z = pk2(r0[4], r0[5]); o0.w = pk2(r0[6], r0[7]);
            o1.x = pk2(r1[0], r1[1]); o1.y = pk2(r1[2], r1[3]); o1.z = pk2(r1[4], r1[5]); o1.w = pk2(r1[6], r1[7]);
            *(GAS u32x4*)(hT + (size_t)(2 * pr) * hT_ld + tsh + 8 * g8) = o0; *(GAS u32x4*)(hT + (size_t)(2 * pr + 1) * hT_ld + tsh + 8 * g8) = o1;
        }
    }
}

__device__ __forceinline__ void attn_unit(Frame& F, int layer, int hk, int qrow0, bool latent, int qb) {
    constexpr int KS = 72, VS = 324;
    LAS bf16* Kt = (LAS bf16*)F.lds;
    LAS bf16* Vt = (LAS bf16*)(F.lds + 46080);
    const bf16* Qb = WSP(bf16, WS_Q); const bf16* Kb = WSP(bf16, WS_K); const bf16* Vb = WSP(bf16, WS_V);
    const int lane = F.lane, r = lane & 31, h = lane >> 5, w = F.wave;
    const int head = hk * 4 + (w >> 1), qt0 = qrow0 + (w & 1) * 64;
    LAS bf16x8* Qs = (LAS bf16x8*)(F.lds + 87552) + w * 512;
#pragma unroll
    for (int qq = 0; qq < 2; ++qq)
#pragma unroll
        for (int s = 0; s < 4; ++s) Qs[(qq * 4 + s) * 64 + lane] = *(const GAS bf16x8*)(Qb + (size_t)(qt0 + 32 * qq + r) * 512 + head * 64 + 16 * s + 8 * h);
    const float sink2 = F.in[I_SINK][layer * 8 + head] * LOG2E;
    float mrun[2] = {sink2, sink2}, lsum[2] = {h == 0 ? 1.f : 0.f, h == 0 ? 1.f : 0.f};
    f32x16 O[2][2];
#pragma unroll
    for (int a = 0; a < 2; ++a)
#pragma unroll
        for (int b = 0; b < 2; ++b)
#pragma unroll
            for (int i = 0; i < 16; ++i) O[a][b][i] = 0.f;
    const int nchunk = latent ? 2 : 1;
    const int skey = F.tid >> 3, sch = F.tid & 7;
    auto tile_row0 = [&](int it, bool& valid, bool& masked) -> int {
        if (it < 4) { valid = true; masked = false; return ML + 64 * it; }
        if (!latent) { valid = false; masked = false; return 0; }
        const int j = it - 4, kb = qb - 1 + (j >> 1); valid = (kb >= 0 && kb < ML / 128); masked = (kb != qb); return kb * 128 + (j & 1) * 64;
    };
#pragma unroll 1
    for (int ch = 0; ch < nchunk; ++ch) {
        __syncthreads();
#pragma unroll 1
        for (int jb = 0; jb < 5; jb += 3) {
            u32x4 kreg[3], vreg[3];
#pragma unroll
            for (int j = 0; j < 3; ++j) { bool v0 = false, m0; int r0 = 0; if (jb + j < 5) r0 = tile_row0(5 * ch + jb + j, v0, m0); kreg[j] = (u32x4){0u, 0u, 0u, 0u}; vreg[j] = kreg[j];
                if (v0) { kreg[j] = *(const GAS u32x4*)(Kb + (size_t)(r0 + skey) * 128 + hk * 64 + 8 * sch); vreg[j] = *(const GAS u32x4*)(Vb + (size_t)(r0 + skey) * 128 + hk * 64 + 8 * sch); } }
#pragma unroll
            for (int j = 0; j < 3; ++j) if (jb + j < 5) {
                *(LAS u32x4*)(Kt + (64 * (jb + j) + skey) * KS + 8 * sch) = kreg[j];
#pragma unroll
                for (int i = 0; i < 4; ++i) { Vt[(8 * sch + 2 * i) * VS + 64 * (jb + j) + skey] = (bf16)(vreg[j][i] & 0xffffu); Vt[(8 * sch + 2 * i + 1) * VS + 64 * (jb + j) + skey] = (bf16)(vreg[j][i] >> 16); } }
        }
        __syncthreads();
#pragma unroll 1
        for (int jt = 0; jt < 5; ++jt) {
        bool valid, masked; const int krow0 = tile_row0(5 * ch + jt, valid, masked);
        if (!valid) continue;
        const LAS bf16* Ktj = Kt + 64 * jt * KS; const LAS bf16* Vtj = Vt + 64 * jt;
        bf16x8 pfr[2][2][2];
#pragma unroll
        for (int qq = 0; qq < 2; ++qq) {
            f32x16 S[2];
#pragma unroll
            for (int kb2 = 0; kb2 < 2; ++kb2) {
                f32x16 acc;
#pragma unroll
                for (int i = 0; i < 16; ++i) acc[i] = 0.f;
#pragma unroll
                for (int s = 0; s < 4; ++s) { const bf16x8 kf = *(const LAS bf16x8*)(Ktj + (32 * kb2 + r) * KS + 16 * s + 8 * h); acc = __builtin_amdgcn_mfma_f32_32x32x16_bf16(kf, Qs[(qq * 4 + s) * 64 + lane], acc, 0, 0, 0); }
                S[kb2] = acc;
            }
            if (masked) {
                const int qi = qt0 + 32 * qq + r;
#pragma unroll
                for (int kb2 = 0; kb2 < 2; ++kb2)
#pragma unroll
                    for (int i = 0; i < 16; ++i) { const int kj = krow0 + 32 * kb2 + (i & 3) + 8 * (i >> 2) + 4 * h; const int df = qi - kj; if (df > 128 || df < -128) S[kb2][i] = -1e30f; }
            }
            float tm = S[0][0];
#pragma unroll
            for (int i = 1; i < 16; ++i) tm = fmaxf(tm, S[0][i]);
#pragma unroll
            for (int i = 0; i < 16; ++i) tm = fmaxf(tm, S[1][i]);
            tm = fmaxf(tm, __shfl_xor(tm, 32));
            const float mn = fmaxf(mrun[qq], tm), alpha = __builtin_amdgcn_exp2f(mrun[qq] - mn); mrun[qq] = mn;
            float ps = 0.f;
#pragma unroll
            for (int kb2 = 0; kb2 < 2; ++kb2)
#pragma unroll
                for (int i = 0; i < 16; ++i) { const float p = __builtin_amdgcn_exp2f(S[kb2][i] - mn); S[kb2][i] = p; ps += p; }
            lsum[qq] = lsum[qq] * alpha + ps;
#pragma unroll
            for (int db = 0; db < 2; ++db)
#pragma unroll
                for (int i = 0; i < 16; ++i) O[db][qq][i] *= alpha;
#pragma unroll
            for (int kb2 = 0; kb2 < 2; ++kb2)
#pragma unroll
                for (int s2 = 0; s2 < 2; ++s2) { u32x4 p;
#pragma unroll
                    for (int i = 0; i < 4; ++i) p[i] = pk2(S[kb2][8 * s2 + 2 * i], S[kb2][8 * s2 + 2 * i + 1]);
                    pfr[qq][kb2][s2] = __builtin_bit_cast(bf16x8, p); }
        }
#pragma unroll
        for (int kb2 = 0; kb2 < 2; ++kb2)
#pragma unroll
            for (int s2 = 0; s2 < 2; ++s2)
#pragma unroll
                for (int db = 0; db < 2; ++db) {
                    const LAS bf16* vp = Vtj + (32 * db + r) * VS + 32 * kb2 + 16 * s2 + 4 * h;
                    const s16x4 lo = *(const LAS s16x4*)vp, hi = *(const LAS s16x4*)(vp + 8);
                    const bf16x8 vf = __builtin_shufflevector(lo, hi, 0, 1, 2, 3, 4, 5, 6, 7);
#pragma unroll
                    for (int qq = 0; qq < 2; ++qq) O[db][qq] = __builtin_amdgcn_mfma_f32_32x32x16_bf16(vf, pfr[qq][kb2][s2], O[db][qq], 0, 0, 0);
                }
        }
    }
    bf16* Ob = WSP(bf16, WS_ABR);
#pragma unroll
    for (int qq = 0; qq < 2; ++qq) {
        const float l = lsum[qq] + __shfl_xor(lsum[qq], 32), inv = 1.f / l;
        bf16* orow = Ob + (size_t)(qt0 + 32 * qq + r) * 512 + head * 64;
#pragma unroll
        for (int db = 0; db < 2; ++db)
#pragma unroll
            for (int g = 0; g < 4; ++g) { u32x2 wv; wv.x = pk2(O[db][qq][4 * g] * inv, O[db][qq][4 * g + 1] * inv); wv.y = pk2(O[db][qq][4 * g + 2] * inv, O[db][qq][4 * g + 3] * inv);
                *(GAS u32x2*)(orow + 32 * db + 8 * g + 4 * h) = wv; }
    }
    __syncthreads();
}
struct TokRec { unsigned e01; unsigned lpos0, lpos1; float w0, w1; unsigned pad0, pad1, pad2; };
__device__ __forceinline__ void p9_ln1_router(Frame& F, int layer) {
    LAS float* RW = (LAS float*)F.lds; constexpr int RWS = 1028;
    volatile LAS unsigned* cnt = F.MISC + 64;
    volatile LAS float* lg = (volatile LAS float*)(F.MISC + 128) + F.wave * 40;
    { const float* rg = F.in[I_RGW] + (size_t)layer * 1024 * 4; const float* re = F.in[I_REW] + (size_t)layer * 1024 * 32;
      f32x4 wv[16];
#pragma unroll
      for (int i = 0; i < 16; ++i) wv[i] = *(const GAS f32x4*)(re + 4 * (F.tid + 512 * i));
#pragma unroll
      for (int i = 0; i < 16; ++i) { const int idx = F.tid + 512 * i, k = idx >> 3, o = 4 + 4 * (idx & 7);
          RW[(o + 0) * RWS + k] = wv[i].x; RW[(o + 1) * RWS + k] = wv[i].y; RW[(o + 2) * RWS + k] = wv[i].z; RW[(o + 3) * RWS + k] = wv[i].w; }
#pragma unroll
      for (int i = 0; i < 2; ++i) { const int k = F.tid + 512 * i; const f32x4 g = *(const GAS f32x4*)(rg + 4 * k); RW[0 * RWS + k] = g.x; RW[1 * RWS + k] = g.y; RW[2 * RWS + k] = g.z; RW[3 * RWS + k] = g.w; }
      if (F.tid < 32) cnt[F.tid] = 0u;
      if (F.tid < 36) ((volatile LAS float*)(F.MISC + 448))[F.tid] = (F.tid < 4) ? F.in[I_RGB][layer * 4 + F.tid] : F.in[I_REB][layer * 32 + F.tid - 4]; }
    __syncthreads();
    const int RPW = (MT + F.G - 1) / F.G, r_lo = F.bid * RPW, r_hi = min(r_lo + RPW, MT);
    const float* MOD = WSP(float, WS_MOD) + (size_t)layer * 2 * 6144;
    const bf16* T1 = WSP(bf16, WS_T1); bf16* X = WSP(bf16, WS_X); bf16* HN = WSP(bf16, WS_HN); TokRec* TR = WSP(TokRec, WS_TOKREC);
    const float* g1 = F.in[I_LN1G] + layer * 1024; const float* b1 = F.in[I_LN1B] + layer * 1024;
    const int lane = F.lane;
    volatile LAS float* lg2 = (volatile LAS float*)(F.lds + 148480) + F.wave * 80;
    volatile LAS float* rbias = (volatile LAS float*)(F.MISC + 448);
    f32x4 gg[4], bb[4], vn[2][4];
#pragma unroll
    for (int j = 0; j < 4; ++j) { gg[j] = *(const GAS f32x4*)(g1 + 4 * lane + 256 * j); bb[j] = *(const GAS f32x4*)(b1 + 4 * lane + 256 * j); }
    const int rfirst = r_lo + F.wave;
#pragma unroll
    for (int q = 0; q < 2; ++q) { const int rr = rfirst + q * NWAVES; row_load_bf16(T1 + (size_t)(rr < r_hi ? rr : r_lo) * 1024, lane, vn[q]); }
#pragma unroll 1
    for (int r = rfirst; r < r_hi; r += 2 * NWAVES) {
        const bool ok1 = r + NWAVES < r_hi;
        const int rq[2] = {r, ok1 ? r + NWAVES : r};
        f32x4 v[2][4];
#pragma unroll
        for (int q = 0; q < 2; ++q)
#pragma unroll
            for (int j = 0; j < 4; ++j) v[q][j] = vn[q][j];
#pragma unroll
        for (int q = 0; q < 2; ++q) { const int rr = r + (2 + q) * NWAVES; if (rr < r_hi) row_load_bf16(T1 + (size_t)rr * 1024, lane, vn[q]); }
#pragma unroll
        for (int q = 0; q < 2; ++q) { row_norm(v[q]);
#pragma unroll
            for (int j = 0; j < 4; ++j) v[q][j] = v[q][j] * gg[j] + bb[j]; }
        row_store_bf16(X + (size_t)rq[0] * 1024, lane, v[0]);
        if (ok1) row_store_bf16(X + (size_t)rq[1] * 1024, lane, v[1]);
#pragma unroll
        for (int q = 0; q < 2; ++q) { const float* md = MOD + (rq[q] >= ML ? 6144 : 0); row_norm(v[q]);
#pragma unroll
            for (int j = 0; j < 4; ++j) v[q][j] = v[q][j] * (*(const GAS f32x4*)(md + 4096 + 4 * lane + 256 * j) + 1.f) + *(const GAS f32x4*)(md + 3072 + 4 * lane + 256 * j); }
        row_store_bf16(HN + (size_t)rq[0] * 1024, lane, v[0]);
        if (ok1) row_store_bf16(HN + (size_t)rq[1] * 1024, lane, v[1]);
        float a[2][36];
#pragma unroll
        for (int ob = 0; ob < 36; ob += 2) {
            f32x4 wv[2][4];
#pragma unroll
            for (int o = 0; o < 2; ++o)
#pragma unroll
                for (int j = 0; j < 4; ++j) wv[o][j] = *(const LAS f32x4*)(RW + (ob + o) * RWS + 4 * lane + 256 * j);
            __builtin_amdgcn_sched_barrier(0);
#pragma unroll
            for (int q = 0; q < 2; ++q)
#pragma unroll
                for (int o = 0; o < 2; ++o) { f32x2 s2 = {0.f, 0.f};
#pragma unroll
                    for (int j = 0; j < 4; ++j) { s2 += (f32x2){v[q][j].x, v[q][j].y} * (f32x2){wv[o][j].x, wv[o][j].y}; s2 += (f32x2){v[q][j].z, v[q][j].w} * (f32x2){wv[o][j].z, wv[o][j].w}; }
                    a[q][ob + o] = s2.x + s2.y; }
            __builtin_amdgcn_sched_barrier(0);
        }
#define BFLY_STAGE(NH, XM) { const bool hi = (lane & XM) != 0; _Pragma("unroll") for (int i = 0; i < NH; ++i) _Pragma("unroll") for (int q = 0; q < 2; ++q) { \
            const float snd = hi ? a[q][i] : a[q][NH + i]; const float rc = __shfl_xor(snd, XM); a[q][i] = (hi ? a[q][NH + i] : a[q][i]) + rc; } }
        BFLY_STAGE(18, 32) BFLY_STAGE(9, 16) a[0][9] = 0.f; a[1][9] = 0.f; BFLY_STAGE(5, 8) a[0][5] = 0.f; a[1][5] = 0.f; BFLY_STAGE(3, 4) a[0][3] = 0.f; a[1][3] = 0.f; BFLY_STAGE(2, 2) BFLY_STAGE(1, 1)
#undef BFLY_STAGE
        { const int i1 = lane & 1, i2 = ((lane >> 1) & 1) * 2 + i1, i3 = ((lane >> 2) & 1) * 3 + i2, i4 = ((lane >> 3) & 1) * 5 + i3, i5 = ((lane >> 4) & 1) * 9 + i4, i6 = ((lane >> 5) & 1) * 18 + i5;
          if (i2 < 3 && i3 < 5 && i4 < 9) { lg2[i6] = a[0][0]; lg2[40 + i6] = a[1][0]; } }
        LDS_WAIT(); asm volatile("" ::: "memory");
#pragma unroll
        for (int q = 0; q < 2; ++q) {
            volatile LAS float* lg = lg2 + 40 * q;
            float l4[4]; int gs = 0;
#pragma unroll
            for (int i = 0; i < 4; ++i) l4[i] = lg[i] + rbias[i];
#pragma unroll
            for (int i = 1; i < 4; ++i) if (l4[i] > l4[gs]) gs = i;
            float den = 0.f;
#pragma unroll
            for (int i = 0; i < 4; ++i) den += __expf(l4[i] - l4[gs]);
            const float gate = 1.f / den;
            float le[8];
#pragma unroll
            for (int i = 0; i < 8; ++i) le[i] = lg[4 + gs * 8 + i] + rbias[4 + gs * 8 + i];
            int i0 = 0;
#pragma unroll
            for (int i = 1; i < 8; ++i) if (le[i] > le[i0]) i0 = i;
            int i1 = (i0 == 0) ? 1 : 0;
#pragma unroll
            for (int i = 0; i < 8; ++i) if (i != i0 && le[i] > le[i1]) i1 = i;
            const float ex = __expf(le[i1] - le[i0]), w0 = gate / (1.f + ex), w1 = gate * ex / (1.f + ex);
            const unsigned e0 = gs * 8 + i0, e1 = gs * 8 + i1;
            if (lane == 0 && (q == 0 || ok1)) {
                const unsigned p0 = __hip_atomic_fetch_add((LAS unsigned*)(cnt + e0), 1u, __ATOMIC_RELAXED, __HIP_MEMORY_SCOPE_WORKGROUP);
                const unsigned p1 = __hip_atomic_fetch_add((LAS unsigned*)(cnt + e1), 1u, __ATOMIC_RELAXED, __HIP_MEMORY_SCOPE_WORKGROUP);
                TokRec t; t.e01 = e0 | (e1 << 8); t.lpos0 = p0; t.lpos1 = p1; t.w0 = w0; t.w1 = w1; t.pad0 = 0; t.pad1 = 0; t.pad2 = 0;
                TR[rq[q]] = t;
            }
        }
    }
    __syncthreads();
    if (F.tid < 32) WSP(unsigned, WS_WGCNT)[F.bid * 32 + F.tid] = cnt[F.tid];
}

__device__ __forceinline__ void p10_slots_gather(Frame& F) {
    volatile LAS unsigned* part = (volatile LAS unsigned*)F.lds;
    const unsigned* WGC = WSP(unsigned, WS_WGCNT);
    if (F.tid < 256) { const int e = F.tid & 31, pt = F.tid >> 5; unsigned tot = 0, mine = 0;
        const int wpp = F.G / 8;
#pragma unroll 32
        for (int w2 = 0; w2 < wpp; ++w2) { const int w = pt * wpp + w2; const unsigned v = __builtin_nontemporal_load(WGC + w * 32 + e); tot += v; if (w < F.bid) mine += v; }
        part[pt * 32 + e] = tot; part[256 + pt * 32 + e] = mine; }
    __syncthreads();
    if (F.tid < 32) { unsigned tot = 0, mine = 0; for (int p = 0; p < 8; ++p) { tot += part[p * 32 + F.tid]; mine += part[256 + p * 32 + F.tid]; } part[512 + F.tid] = tot; part[544 + F.tid] = mine; }
    __syncthreads();
    if (F.tid == 0) { unsigned pst = 0; int* PE = WSP(int, WS_PANEL);
        for (int e = 0; e < 32; ++e) { const unsigned np = (part[512 + e] + 255u) >> 8; part[576 + e] = pst * 256u + part[544 + e];
            if (F.bid == 0) for (unsigned p = 0; p < np; ++p) PE[pst + p] = e;
            pst += np; }
        if (F.bid == 0) PE[256] = (int)pst; }
    __syncthreads();
    const int RPW = (MT + F.G - 1) / F.G, r_lo = F.bid * RPW, r_hi = min(r_lo + RPW, MT);
    const TokRec* TR = WSP(TokRec, WS_TOKREC); int* TS = WSP(int, WS_TOKSLOT); int* RT = WSP(int, WS_ROWTOK);
    for (int r = r_lo + F.tid; r < r_hi; r += 512) {
        const TokRec t = TR[r];
        const unsigned s0 = part[576 + (t.e01 & 255u)] + t.lpos0, s1 = part[576 + (t.e01 >> 8)] + t.lpos1;
        RT[s0] = r; RT[s1] = r; TS[2 * r] = (int)s0; TS[2 * r + 1] = (int)s1;
    }
    if (F.bid < 32) { const unsigned e = F.bid, tot = part[512 + e], np = (tot + 255u) >> 8; const unsigned first = part[576 + e] - part[544 + e] + tot, endp = part[576 + e] - part[544 + e] + np * 256u;
        for (unsigned s = first + F.tid; s < endp; s += 512) RT[s] = 0; }
}

__device__ __forceinline__ void p13_ln2(Frame& F, int layer) {
    const int gw = F.vcu * NWAVES + F.wave, NGW = F.G * NWAVES, lane = F.lane;
    const float* MOD = WSP(float, WS_MOD) + (size_t)layer * 2 * 6144; const float* MODN = MOD + 2 * 6144;
    bf16* X = WSP(bf16, WS_X); bf16* XN = WSP(bf16, WS_XN); const bf16* YS = WSP(bf16, WS_YS); const TokRec* TR = WSP(TokRec, WS_TOKREC); const int* TS = WSP(int, WS_TOKSLOT);
    const float* g2 = F.in[I_LN2G] + layer * 1024; const float* b2 = F.in[I_LN2B] + layer * 1024;
    const bool last = (layer == NLAYER - 1);
    const int rend = last ? ML : MT;
    TokRec tn; int s0n = 0, s1n = 0; f32x4 vn[4]; u32x2 yan[4], ybn[4];
    if (gw < rend) { tn = TR[gw]; s0n = TS[2 * gw]; s1n = TS[2 * gw + 1]; row_load_bf16(X + (size_t)gw * 1024, lane, vn);
#pragma unroll
        for (int j = 0; j < 4; ++j) { yan[j] = *(const GAS u32x2*)(YS + (size_t)s0n * 1024 + 4 * lane + 256 * j); ybn[j] = *(const GAS u32x2*)(YS + (size_t)s1n * 1024 + 4 * lane + 256 * j); } }
#pragma unroll 1
    for (int r = gw; r < rend; r += NGW) {
        const bool isc = r >= ML; const float* md = MOD + (isc ? 6144 : 0);
        const TokRec t = tn; f32x4 v[4]; u32x2 yav[4], ybv[4];
#pragma unroll
        for (int j = 0; j < 4; ++j) { v[j] = vn[j]; yav[j] = yan[j]; ybv[j] = ybn[j]; }
        const int rn = r + NGW;
        if (rn < rend) { tn = TR[rn]; s0n = TS[2 * rn]; s1n = TS[2 * rn + 1]; row_load_bf16(X + (size_t)rn * 1024, lane, vn);
#pragma unroll
            for (int j = 0; j < 4; ++j) { yan[j] = *(const GAS u32x2*)(YS + (size_t)s0n * 1024 + 4 * lane + 256 * j); ybn[j] = *(const GAS u32x2*)(YS + (size_t)s1n * 1024 + 4 * lane + 256 * j); } }
#pragma unroll
        for (int j = 0; j < 4; ++j) {
            const u32x2 ya = yav[j], yb = ybv[j];
            f32x4 f; f.x = t.w0 * bflo(ya.x) + t.w1 * bflo(yb.x); f.y = t.w0 * bfhi(ya.x) + t.w1 * bfhi(yb.x); f.z = t.w0 * bflo(ya.y) + t.w1 * bflo(yb.y); f.w = t.w0 * bfhi(ya.y) + t.w1 * bfhi(yb.y);
            v[j] = v[j] * DN_ALPHA + *(const GAS f32x4*)(md + 5120 + 4 * lane + 256 * j) * f;
        }
        row_norm(v);
#pragma unroll
        for (int j = 0; j < 4; ++j) v[j] = v[j] * *(const GAS f32x4*)(g2 + 4 * lane + 256 * j) + *(const GAS f32x4*)(b2 + 4 * lane + 256 * j);
        if (last) {
#pragma unroll
            for (int j = 0; j < 4; ++j) *(GAS f32x4*)(F.out + (size_t)r * 1024 + 4 * lane + 256 * j) = v[j];
        } else {
            row_store_bf16(X + (size_t)r * 1024, lane, v);
            const float* mn = MODN + (isc ? 6144 : 0);
            row_norm(v);
#pragma unroll
            for (int j = 0; j < 4; ++j) v[j] = v[j] * (*(const GAS f32x4*)(mn + 1024 + 4 * lane + 256 * j) + 1.f) + *(const GAS f32x4*)(mn + 4 * lane + 256 * j);
            row_store_bf16(XN + (size_t)r * 1024, lane, v);
        }
    }
}
typedef float f32x4v __attribute__((ext_vector_type(4)));
__device__ __forceinline__ f32x4 ctx_reduce_halves(Frame& F, f32x4 acc) {
    LAS f32x4* red = (LAS f32x4*)F.lds;
    __syncthreads();
    if (F.wave >= 4) red[(F.wave - 4) * 64 + F.lane] = acc;
    __syncthreads();
    if (F.wave < 4) acc += red[F.wave * 64 + F.lane];
    return acc;
}
__device__ __forceinline__ void ctx_branch_item(Frame& F, int item) {
    const int s = item >> 4, ch = item & 15, cg = F.wave & 3, kh = F.wave >> 2, fr = F.lane & 15, fq = F.lane >> 4;
    const int row = ML + 16 * s + fr, col = 64 * ch + 16 * cg;
    const bf16* GATE = WSP(bf16, WS_GATE) + (size_t)row * 4096 + col + 4 * fq;
    f32x4 merged = {0.f, 0.f, 0.f, 0.f};
#pragma unroll 1
    for (int n = 0; n < 4; ++n) {
        const bf16* A = WSP(bf16, WS_ABR) + ((size_t)n * MT + row) * 512 + kh * 256 + 8 * fq;
        const bf16* B = WSP(bf16, WS_WBR) + ((size_t)n * 1024 + col + fr) * 512 + kh * 256 + 8 * fq;
        bf16x8 af[8], bfr[8];
#pragma unroll
        for (int k = 0; k < 8; ++k) { af[k] = *(const GAS bf16x8*)(A + 32 * k); bfr[k] = *(const GAS bf16x8*)(B + 32 * k); }
        const u32x2 gw = *(const GAS u32x2*)(GATE + n * 1024);
        f32x4 acc = {0.f, 0.f, 0.f, 0.f};
#pragma unroll
        for (int k = 0; k < 8; ++k) acc = __builtin_amdgcn_mfma_f32_16x16x32_bf16(bfr[k], af[k], acc, 0, 0, 0);
        f32x4 g; g.x = bflo(gw.x); g.y = bfhi(gw.x); g.z = bflo(gw.y); g.w = bfhi(gw.y);
        merged += g * acc;
    }
    merged = ctx_reduce_halves(F, merged);
    if (F.wave < 4) { u32x2 w; w.x = pk2(merged.x, merged.y); w.y = pk2(merged.z, merged.w); *(GAS u32x2*)(WSP(bf16, WS_MERGED) + (size_t)row * 1024 + col + 4 * fq) = w; }
}
__device__ __forceinline__ void ctx_out_item(Frame& F, int layer, int item) {
    const int s = item >> 4, ch = item & 15, cg = F.wave & 3, kh = F.wave >> 2, fr = F.lane & 15, fq = F.lane >> 4;
    const int row = ML + 16 * s + fr, col = 64 * ch + 16 * cg;
    const bf16* A = WSP(bf16, WS_MERGED) + (size_t)row * 1024 + kh * 512 + 8 * fq;
    const bf16* B = WSP(bf16, WS_WOUT) + (size_t)(col + fr) * 1024 + kh * 512 + 8 * fq;
    f32x4 acc = {0.f, 0.f, 0.f, 0.f};
#pragma unroll 1
    for (int k0 = 0; k0 < 2; ++k0) {
        bf16x8 af[8], bfr[8];
#pragma unroll
        for (int k = 0; k < 8; ++k) { af[k] = *(const GAS bf16x8*)(A + 256 * k0 + 32 * k); bfr[k] = *(const GAS bf16x8*)(B + 256 * k0 + 32 * k); }
#pragma unroll
        for (int k = 0; k < 8; ++k) acc = __builtin_amdgcn_mfma_f32_16x16x32_bf16(bfr[k], af[k], acc, 0, 0, 0);
    }
    acc = ctx_reduce_halves(F, acc);
    if (F.wave < 4) {
        f32x4 x;
        if (layer == 0) x = *(const GAS f32x4*)(F.in[I_CTX] + (size_t)(row - ML) * 1024 + col + 4 * fq);
        else { const u32x2 w = *(const GAS u32x2*)(WSP(bf16, WS_X) + (size_t)row * 1024 + col + 4 * fq); x.x = bflo(w.x); x.y = bfhi(w.x); x.z = bflo(w.y); x.w = bfhi(w.y); }
        const f32x4 g1 = *(const GAS f32x4*)(WSP(float, WS_MOD) + ((size_t)layer * 2 + 1) * 6144 + 2048 + col + 4 * fq);
        const f32x4 o = x * DN_ALPHA + g1 * acc;
        u32x2 ow; ow.x = pk2(o.x, o.y); ow.y = pk2(o.z, o.w);
        *(GAS u32x2*)(WSP(bf16, WS_T1) + (size_t)row * 1024 + col + 4 * fq) = ow;
    }
}
__global__ void __launch_bounds__(NWAVES * 64, 2) fwd_kernel(Args args) {
    extern __shared__ __attribute__((aligned(16))) unsigned char lds_raw[];
    Frame F;
    F.lds = (LAS unsigned char*)lds_raw;
    F.MISC = (volatile LAS unsigned*)(F.lds + MISC_OFF);
    F.tid = threadIdx.x; F.lane = F.tid & 63; F.wave = __builtin_amdgcn_readfirstlane(F.tid >> 6);
    F.G = gridDim.x; F.bid = blockIdx.x; F.vcu = (F.G % 8 == 0) ? (F.bid % 8) * (F.G / 8) + F.bid / 8 : F.bid;
    F.in = args.in; F.ws = args.ws; F.out = args.out;
    for (int u = F.tid; u < (LDS_BYTES - MISC_OFF) / 4; u += NWAVES * 64) F.MISC[u] = 0u;
    __syncthreads();
    XcdBarrier bar = xcd_barrier_post((unsigned*)(F.ws + WS_CTL) + CW_BAR, F.MISC + 8);
#define LAUNDER_PTR(T, dst, src) do { unsigned long long p_ = (unsigned long long)(src); unsigned lo_ = (unsigned)p_, hi_ = (unsigned)(p_ >> 32); asm volatile("" : "+v"(lo_), "+v"(hi_)); lo_ = __builtin_amdgcn_readfirstlane(lo_); hi_ = __builtin_amdgcn_readfirstlane(hi_); (dst) = (T)(((unsigned long long)hi_ << 32) | lo_); } while (0)
#define GRID_BAR() do { XcdBarrier b2_ = bar; LAUNDER_PTR(unsigned*, b2_.bar, bar.bar); b2_.x = xb_xcc_id(); xcd_barrier(b2_); } while (0)
    using namespace pg8;
    LAS unsigned char* ring = F.lds;

#ifndef PH_MASK
#define PH_MASK 0xffffffffu
#endif
#define PH(k) if constexpr (((PH_MASK) >> (k)) & 1u)
#define PHASE_BEGIN() do { F.tid = threadIdx.x; F.bid = blockIdx.x; asm volatile("" : "+v"(F.tid), "+s"(F.bid)); F.vcu = (F.G % 8 == 0) ? (F.bid % 8) * (F.G / 8) + F.bid / 8 : F.bid; LAUNDER_PTR(unsigned char*, F.ws, args.ws); F.in = args.in; F.lane = F.tid & 63; F.wave = __builtin_amdgcn_readfirstlane(F.tid >> 6); } while (0)
#ifndef PROBE_REP
#define PROBE_REP 0u
#endif
#ifndef PROBE_N
#define PROBE_N 3
#endif
#define REPN(k) ((((PROBE_REP) >> (k)) & 1u) ? PROBE_N : 1)
#define REP(k) _Pragma("unroll") for (int rep_ = 0; rep_ < REPN(k); ++rep_)
#define REPU(k) _Pragma("unroll") for (int repu_ = 0; repu_ < REPN(k); ++repu_)
    PH(0) { p0_mods(F); p0_tables(F); }
    GRID_BAR();

#ifndef LAYER_UNROLL
#define LAYER_UNROLL 4
#endif
#pragma unroll LAYER_UNROLL
    for (int layer = 0; layer < NLAYER; ++layer) {
        const bool last = (layer == NLAYER - 1);
        PHASE_BEGIN();
        REP(0) {
        if (layer == 0) { PH(4) { p_xn0(F); } } else { PH(17) { if (rep_ == 0) p13_ln2(F, layer - 1); } }
        PH(1) { p1_convert(F, layer); }
        __syncthreads(); PHASE_BEGIN();
        PH(2) { Gemm g{WSP(bf16_t, WS_W3T) + (size_t)layer * 2048 * 128, WSP(bf16_t, WS_HDN2B) + (size_t)layer * ML * 128, 2048, ML, 128};
          StaticOrder S; S.init(2048, ML, F.G, F.bid); EpiPlain E; E.O = WSP(bf16_t, WS_TAPS); E.ldc = ML;
          gemm_phase<EpiPlain, StaticOrder, true, true>(ring, g, S, E); }
        GRID_BAR(); PHASE_BEGIN();
        }
        REP(2) {
        PH(5) { Gemm g{WSP(bf16_t, WS_XN), WSP(bf16_t, WS_WIN), MT, INCOLS, 1024};
          StaticOrder S; S.init(MT, INCOLS, F.G, F.bid);
          EpiInProj E; E.Q = WSP(bf16_t, WS_Q); E.K = WSP(bf16_t, WS_K); E.V = WSP(bf16_t, WS_V); E.POOL = WSP(bf16_t, WS_POOL); E.HY = WSP(bf16_t, WS_HY); E.SC = WSP(bf16_t, WS_SC); E.GATE = WSP(bf16_t, WS_GATE);
          E.rcos = WSP(float, WS_ROPE); E.rsin = E.rcos + 320 * 16; E.n_lat = ML; E.qscale = QSCALE;
          gemm_phase<EpiInProj, StaticOrder, true, true>(ring, g, S, E); }
        GRID_BAR(); PHASE_BEGIN();
        }
        REP(3) {
        { const int natt = last ? 256 : 260;
          PH(6) REPU(12) {
#pragma unroll 1
          for (int it2 = 0; ; ++it2) {
              int u;
              if (F.G == 256) { if (it2 == 0) u = F.vcu; else if (it2 == 1) u = (natt > 256 && F.vcu >= 252) ? 256 + (255 - F.vcu) : -1; else break; }
              else { u = F.vcu + it2 * F.G; if (u >= natt) break; }
              if (u < 0) continue;
              if (u < 256) attn_unit(F, layer, u & 1, (u >> 1) * 128, true, u >> 1);
              else { const int uc = u - 256; attn_unit(F, layer, uc & 1, ML + (uc >> 1) * 128, false, 0); }
          } }
          const int nblk = last ? 256 : 260;
          PH(7) REP(13) {
#pragma unroll 1
          for (int b = F.vcu; b < nblk; b += F.G) {
              if (b < 256) token_block_item(F, layer, 0, ML, b * 64, WSP(bf16, WS_HT), ML);
              else token_block_item(F, layer, ML, MC, (b - 256) * 64, WSP(bf16, WS_HTC), MC);
          }
          } }
        __syncthreads(); PHASE_BEGIN();
        PH(3) REP(1) {
        ptw_init(F);
#pragma unroll 1
        for (int u = F.vcu; u < 1024; u += F.G) filter_unit(F, u); }
        GRID_BAR(); PHASE_BEGIN();
        }
        REP(4) {
        PH(8) {
        ptw_init(F);
#pragma unroll 1
        for (int u = F.vcu; u < 256; u += F.G) hyena_unit(F, layer, u); }
        PH(9) if (!last) {
#pragma unroll 1
            for (int u = F.vcu; u < 256; u += F.G) hyena_ctx_unit(F, layer, u);
        }
        GRID_BAR(); PHASE_BEGIN();
        }
        REP(6) {
        PH(11) { Gemm g{WSP(bf16_t, WS_ABR), WSP(bf16_t, WS_WBR), 4 * MT, 4096, 512};
          BranchOrder S; S.G = F.G; S.c = F.vcu; S.ntile = (ML / 256) * 4; S.npan = NPANEL;
          EpiBranch E; E.GATE = WSP(bf16_t, WS_GATE); E.MERGED = WSP(bf16_t, WS_MERGED); E.npan = NPANEL;
          gemm_phase<EpiBranch, BranchOrder, true, true>(ring, g, S, E); }
        if (!last) { __syncthreads();
#pragma unroll 1
          for (int it = F.vcu; it < 256; it += F.G) ctx_branch_item(F, it); }
        GRID_BAR(); PHASE_BEGIN();
        }
        REP(7) {
        PH(12) { Gemm g{WSP(bf16_t, WS_MERGED), WSP(bf16_t, WS_WOUT), ML, 1024, 1024};
          StaticOrder S; S.init(ML, 1024, F.G, F.bid);
          EpiOut E; E.xf = layer == 0 ? F.in[I_X] : nullptr; E.xb = WSP(bf16_t, WS_X); E.g1l = WSP(float, WS_MOD) + (size_t)layer * 2 * 6144 + 2048; E.T1 = WSP(bf16_t, WS_T1);
          gemm_phase<EpiOut, StaticOrder, true, true>(ring, g, S, E); }
        if (!last) { __syncthreads();
#pragma unroll 1
          for (int it = F.vcu; it < 256; it += F.G) ctx_out_item(F, layer, it); }
        GRID_BAR(); PHASE_BEGIN();
        }
        REP(8) {
        PH(13) { p9_ln1_router(F, layer); }
        GRID_BAR(); PHASE_BEGIN();
        }
        REP(9) {
        PH(14) { p10_slots_gather(F); }
        GRID_BAR(); PHASE_BEGIN();
        }
        { const int* PE = WSP(int, WS_PANEL); const int npan = PE[256];
          REP(10) {
          PH(15) { LAS int* rowtab = (LAS int*)(F.lds + 131072);
            { const int* RT = WSP(int, WS_ROWTOK);
#pragma unroll 1
              for (int ui = 0; ui < 4; ++ui) { const int L = ui * F.G + F.vcu; if (L < npan * 4 && F.tid < 256) rowtab[ui * 256 + F.tid] = RT[(L >> 2) * 256 + F.tid]; } }
            __syncthreads();
            Gemm g{WSP(bf16_t, WS_HN), WSP(bf16_t, WS_W13), MT, 32 * 1024, 1024};
            ExpertOrder S; S.G = F.G; S.c = F.vcu; S.panel_e = PE; S.npanels = npan; EpiE1 E; E.H = WSP(bf16_t, WS_HS);
            gemm_phase_ga<EpiE1, ExpertOrder, true, true>(ring, g, S, E, rowtab); }
          GRID_BAR(); PHASE_BEGIN();
          }
          REP(11) {
          PH(16) { Gemm g{WSP(bf16_t, WS_HS), WSP(bf16_t, WS_W2), SMAXP * 256, 32 * 1024, 512};
            ExpertOrder S; S.G = F.G; S.c = F.vcu; S.panel_e = PE; S.npanels = npan; EpiE2 E; E.Y = WSP(bf16_t, WS_YS);
            gemm_phase<EpiE2, ExpertOrder, true, true>(ring, g, S, E); }
          GRID_BAR(); PHASE_BEGIN();
          } }
        if (last) { PH(17) { p13_ln2(F, layer); } }
    }
}

extern "C" void kernel_launch(void* const* d_in, const int* in_sizes, int n_in, void* d_out, int out_size, void* d_ws, size_t ws_size, hipStream_t stream) {
    static int grid = 0;
    if (grid == 0) {
        if (n_in != 34 || out_size != ML * DM || ws_size < WS_END) { fprintf(stderr, "kernel_launch: unexpected shapes (n_in %d out %d ws %zu)\n", n_in, out_size, ws_size); grid = -1; return; }
        int dev = 0, cus = 0;
        if (hipGetDevice(&dev) != hipSuccess || hipDeviceGetAttribute(&cus, hipDeviceAttributeMultiprocessorCount, dev) != hipSuccess) { grid = -1; return; }
        if (hipFuncSetAttribute((const void*)fwd_kernel, hipFuncAttributeMaxDynamicSharedMemorySize, LDS_BYTES) != hipSuccess) { fprintf(stderr, "kernel_launch: hipFuncSetAttribute failed\n"); grid = -1; return; }
        int per_cu = 0;
        if (hipOccupancyMaxActiveBlocksPerMultiprocessor(&per_cu, (const void*)fwd_kernel, NWAVES * 64, LDS_BYTES) != hipSuccess || per_cu < 1) fprintf(stderr, "kernel_launch: occupancy query says %d\n", per_cu);
        (void)hipGetLastError();
        grid = cus - (cus % 8);
        if (grid > 256) grid = 256;
    }
    if (grid < 0) return;
    (void)hipMemsetAsync((char*)d_ws + WS_CTL, 0, CTL_ZERO_BYTES, stream);
    Args a{};
    for (int i = 0; i < 34; ++i) a.in[i] = (const float*)d_in[i];
    a.out = (float*)d_out; a.ws = (unsigned char*)d_ws;
    hipLaunchKernelGGL(fwd_kernel, dim3(grid), dim3(NWAVES * 64), LDS_BYTES, stream, a);
}
```
